# Optimizing an MI355X kernel written in HIP

```python
import math
import jax, jax.numpy as jnp
from jax import lax
import numpy as np

D_MODEL = 2048
BATCH = 8
SEQ = 4096
DEPTH = 2

CTX_LEN = 256
GRID_W = 64
N_MIXERS = 2
N_FOURIER_LAYERS = (DEPTH + 1) // 2
N_ATTN_LAYERS = DEPTH // 2
FOURIER_GROUPS = 8
FOURIER_GROUP_DIM = D_MODEL // FOURIER_GROUPS
HEAD_DIM = 128
N_HEADS = D_MODEL // HEAD_DIM
N_KV_HEADS = 4
GQA_GROUP = N_HEADS // N_KV_HEADS
Q_DIM = N_HEADS * HEAD_DIM
KV_DIM = N_KV_HEADS * HEAD_DIM
ROPE_FREQS = HEAD_DIM // 4
ROPE_THETA = 10000.0
Q_BLOCK = 128
D_FF = 5632
N_MOD = 9
EPS = 1e-6

kernel_name = "hybrid_fourier_gqa_macaron_dit"


def rmsnorm(x, g):
    xf = x.astype(jnp.float32)
    y = xf * lax.rsqrt(jnp.mean(xf * xf, axis=-1, keepdims=True) + EPS)
    return (y * g.astype(jnp.float32)).astype(x.dtype)


def modulate(x, g, shift, scale):
    return rmsnorm(x, g) * (1.0 + scale) + shift


def swiglu(h, w_in, w_out):
    gate, up = jnp.split(h @ w_in, 2, axis=-1)
    return (jax.nn.silu(gate) * up) @ w_out


def axial_rope_tables(n_tokens):
    rows = n_tokens // GRID_W
    row = jnp.repeat(jnp.arange(rows), GRID_W).astype(jnp.float32)
    col = jnp.tile(jnp.arange(GRID_W), rows).astype(jnp.float32)
    inv_freq = ROPE_THETA ** (-jnp.arange(ROPE_FREQS, dtype=jnp.float32) / ROPE_FREQS)
    a_r = row[:, None] * inv_freq
    a_c = col[:, None] * inv_freq
    ang = jnp.concatenate([a_r, a_r, a_c, a_c], axis=-1)
    return jnp.cos(ang), jnp.sin(ang)


def apply_axial_rope(x, cos, sin):
    xs = x.astype(jnp.float32).reshape(*x.shape[:-1], 2, 2, ROPE_FREQS)
    x1, x2 = xs[..., 0, :], xs[..., 1, :]
    rot = jnp.stack([-x2, x1], axis=-2).reshape(x.shape)
    return (x.astype(jnp.float32) * cos[:, None, :] + rot * sin[:, None, :]).astype(x.dtype)


def fourier_mix(h, w_out):
    b, n, _ = h.shape
    hg = h.astype(jnp.float32).reshape(b, n, FOURIER_GROUPS, FOURIER_GROUP_DIM)
    f = jnp.fft.fft2(hg, axes=(1, 3), norm="ortho").real
    return f.reshape(b, n, D_MODEL).astype(h.dtype) @ w_out


def gqa_mix(h_lat, h_ctx, w_qkv, q_g, k_g, w_o, cos, sin, need_ctx):
    b, s, _ = h_lat.shape
    l = h_ctx.shape[1]
    scale = 1.0 / math.sqrt(HEAD_DIM)

    q_l, k_l, v_l = jnp.split(h_lat @ w_qkv, [Q_DIM, Q_DIM + KV_DIM], axis=-1)
    q_l = apply_axial_rope(rmsnorm(q_l.reshape(b, s, N_HEADS, HEAD_DIM), q_g), cos, sin)
    k_l = apply_axial_rope(rmsnorm(k_l.reshape(b, s, N_KV_HEADS, HEAD_DIM), k_g), cos, sin)
    v_l = v_l.reshape(b, s, N_KV_HEADS, HEAD_DIM)

    if need_ctx:
        q_c, k_c, v_c = jnp.split(h_ctx @ w_qkv, [Q_DIM, Q_DIM + KV_DIM], axis=-1)
    else:
        k_c, v_c = jnp.split(h_ctx @ w_qkv[:, Q_DIM:], [KV_DIM], axis=-1)
    k_c = rmsnorm(k_c.reshape(b, l, N_KV_HEADS, HEAD_DIM), k_g)
    v_c = v_c.reshape(b, l, N_KV_HEADS, HEAD_DIM)

    k_all = jnp.concatenate([k_c, k_l], axis=1).transpose(0, 2, 1, 3)
    v_all = jnp.concatenate([v_c, v_l], axis=1).transpose(0, 2, 1, 3)

    n_blk = s // Q_BLOCK
    qb = q_l.reshape(b, n_blk, Q_BLOCK, N_KV_HEADS, GQA_GROUP, HEAD_DIM).transpose(1, 0, 3, 4, 2, 5)

    def attend(q_blk):
        sc = jnp.einsum('bkgqd,bkld->bkgql', q_blk, k_all).astype(jnp.float32) * scale
        p = jax.nn.softmax(sc, axis=-1).astype(v_all.dtype)
        return jnp.einsum('bkgql,bkld->bkgqd', p, v_all)

    o = lax.map(attend, qb)
    o = o.transpose(1, 0, 4, 2, 3, 5).reshape(b, s, Q_DIM)
    out_lat = o @ w_o

    out_ctx = None
    if need_ctx:
        qc = rmsnorm(q_c.reshape(b, l, N_HEADS, HEAD_DIM), q_g)
        qc = qc.reshape(b, l, N_KV_HEADS, GQA_GROUP, HEAD_DIM).transpose(0, 2, 3, 1, 4)
        kc = k_c.transpose(0, 2, 1, 3)
        vc = v_c.transpose(0, 2, 1, 3)
        sc = jnp.einsum('bkgqd,bkld->bkgql', qc, kc).astype(jnp.float32) * scale
        p = jax.nn.softmax(sc, axis=-1).astype(vc.dtype)
        oc = jnp.einsum('bkgql,bkld->bkgqd', p, vc).transpose(0, 3, 1, 2, 4).reshape(b, l, Q_DIM)
        out_ctx = oc @ w_o
    return out_lat, out_ctx


def setup_inputs(seed: int = 0) -> dict:
    key = jax.random.key(seed)
    ks = jax.random.split(key, 14)
    f32 = jnp.float32
    d = D_MODEL
    nrm = lambda k, shape, s: jax.random.normal(k, shape, f32) * s
    return {
        "x": nrm(ks[0], (BATCH, SEQ, d), 1.0),
        "c": nrm(ks[1], (BATCH, d), 1.0),
        "ctx": nrm(ks[2], (BATCH, CTX_LEN, d), 1.0),
        "c_ctx": nrm(ks[3], (d,), 1.0),
        "w_ada": nrm(ks[4], (DEPTH, d, N_MOD * d), 0.5 * d ** -0.5),
        "b_ada": nrm(ks[5], (DEPTH, N_MOD * d), 0.01),
        "norm_g": 1.0 + nrm(ks[6], (DEPTH, 3, d), 0.01),
        "w_ffn_in": nrm(ks[7], (DEPTH, 2, d, 2 * D_FF), d ** -0.5),
        "w_ffn_out": nrm(ks[8], (DEPTH, 2, D_FF, d), D_FF ** -0.5),
        "w_fourier_out": nrm(ks[9], (N_FOURIER_LAYERS, d, d), d ** -0.5),
        "w_qkv": nrm(ks[10], (N_ATTN_LAYERS, d, Q_DIM + 2 * KV_DIM), d ** -0.5),
        "q_norm_g": 1.0 + nrm(ks[11], (N_ATTN_LAYERS, HEAD_DIM), 0.01),
        "k_norm_g": 1.0 + nrm(ks[12], (N_ATTN_LAYERS, HEAD_DIM), 0.01),
        "w_attn_out": nrm(ks[13], (N_ATTN_LAYERS, Q_DIM, d), Q_DIM ** -0.5),
    }


def reference(x, c, ctx, c_ctx, w_ada, b_ada, norm_g, w_ffn_in, w_ffn_out,
              w_fourier_out, w_qkv, q_norm_g, k_norm_g, w_attn_out):
    b, n, d = x.shape
    cos, sin = axial_rope_tables(n)
    s_c = jax.nn.silu(c)
    s_cc = jax.nn.silu(c_ctx)

    for i in range(DEPTH):
        last = i == DEPTH - 1
        mixer = i % N_MIXERS
        j = i // N_MIXERS
        m_l = (s_c @ w_ada[i] + b_ada[i]).reshape(b, N_MOD, d)[:, :, None, :]
        m_c = (s_cc @ w_ada[i] + b_ada[i]).reshape(N_MOD, d)
        mod_l = [m_l[:, k] for k in range(N_MOD)]
        mod_c = [m_c[k] for k in range(N_MOD)]
        ctx_feeds_latent = (not last) or mixer == 1

        x = x + 0.5 * mod_l[2] * swiglu(modulate(x, norm_g[i, 0], mod_l[0], mod_l[1]),
                                        w_ffn_in[i, 0], w_ffn_out[i, 0])
        if ctx_feeds_latent:
            ctx = ctx + 0.5 * mod_c[2] * swiglu(modulate(ctx, norm_g[i, 0], mod_c[0], mod_c[1]),
                                                w_ffn_in[i, 0], w_ffn_out[i, 0])

        h_l = modulate(x, norm_g[i, 1], mod_l[3], mod_l[4])
        if mixer == 0:
            x = x + mod_l[5] * fourier_mix(h_l, w_fourier_out[j])
            if not last:
                h_c = modulate(ctx, norm_g[i, 1], mod_c[3], mod_c[4])
                ctx = ctx + mod_c[5] * fourier_mix(h_c, w_fourier_out[j])
        else:
            h_c = modulate(ctx, norm_g[i, 1], mod_c[3], mod_c[4])
            o_l, o_c = gqa_mix(h_l, h_c, w_qkv[j], q_norm_g[j], k_norm_g[j], w_attn_out[j],
                               cos, sin, need_ctx=not last)
            x = x + mod_l[5] * o_l
            if not last:
                ctx = ctx + mod_c[5] * o_c

        x = x + 0.5 * mod_l[8] * swiglu(modulate(x, norm_g[i, 2], mod_l[6], mod_l[7]),
                                        w_ffn_in[i, 1], w_ffn_out[i, 1])
        if not last:
            ctx = ctx + 0.5 * mod_c[8] * swiglu(modulate(ctx, norm_g[i, 2], mod_c[6], mod_c[7]),
                                                w_ffn_in[i, 1], w_ffn_out[i, 1])
    return x
```

```cpp
#include <hip/hip_runtime.h>
#include <cstdio>
#include <cstdint>

#ifndef MK_ONE_LAUNCH
#define MK_ONE_LAUNCH 0
#endif

#define GAS __attribute__((address_space(1)))
#define LAS __attribute__((address_space(3)))
#define PG8_LAS __attribute__((address_space(3)))

constexpr int NB = 8, SEQ = 4096, DM = 2048, CTXL = 256, FF = 5632, NMOD = 9;
constexpr int ML = NB * SEQ, MC = NB * CTXL, MA = ML + MC;
constexpr int NQKV = 3072, HD = 128, NH = 16, NKV = 4, SKV = SEQ + CTXL;
constexpr int MODLD = NMOD * DM;
constexpr float EPS = 1e-6f;

constexpr size_t MiB = 1u << 20;
constexpr size_t WS_CTL = 0, CTL_ZERO_BYTES = 1 * MiB;
constexpr size_t WS_MOD = 1 * MiB;
constexpr size_t WS_TAB = 3 * MiB;
constexpr size_t WS_WC = 4 * MiB;
constexpr size_t WS_SEQ = 5 * MiB;
constexpr size_t WS_WIN = 69 * MiB;
constexpr size_t WS_WOUT = 245 * MiB;
constexpr size_t WS_WFO = 333 * MiB, WS_WQKV = 341 * MiB, WS_WAO = 353 * MiB;
constexpr size_t WS_XC = 361 * MiB;
constexpr size_t WS_H = 377 * MiB;
constexpr size_t WS_HID = 513 * MiB;
constexpr size_t WS_PQT = WS_HID, WS_PQTC = WS_HID + 256 * MiB;
constexpr size_t WS_F = 887 * MiB;
constexpr size_t WS_Q = 1023 * MiB;
constexpr size_t WS_K = 1151 * MiB, WS_V = 1185 * MiB;
constexpr size_t WS_O = 1219 * MiB;
constexpr size_t WS_END = 1347 * MiB;
constexpr size_t WIN_BYTES = (size_t)2 * FF * DM * 2, WOUT_BYTES = (size_t)DM * FF * 2;
constexpr int CW_BAR = 4096;

constexpr int RING_BYTES = 131072, XCH_OFF = RING_BYTES  , MISC_OFF = RING_BYTES + 8192 + 320, LDS_BYTES = 147456;

typedef unsigned short bf16;
typedef unsigned v4u __attribute__((ext_vector_type(4)));
typedef unsigned v2u __attribute__((ext_vector_type(2)));
typedef float f32x4 __attribute__((ext_vector_type(4)));
#define LDS_WAIT() asm volatile("s_waitcnt lgkmcnt(0)" ::: "memory")
#define VM_WAIT() asm volatile("s_waitcnt vmcnt(0)" ::: "memory")
__device__ __forceinline__ unsigned f2bf(float f) { unsigned u = __builtin_bit_cast(unsigned, f); return (u + 0x7fffu + ((u >> 16) & 1u)) >> 16; }
__device__ __forceinline__ unsigned pk2(float lo, float hi) { return f2bf(lo) | (f2bf(hi) << 16); }
__device__ __forceinline__ unsigned cvt_pk_bf16(float lo, float hi) { unsigned r; asm volatile("v_cvt_pk_bf16_f32 %0, %1, %2" : "=v"(r) : "v"(lo), "v"(hi)); return r; }
__device__ __forceinline__ float wave_sum(float v) {
#pragma unroll
    for (int o = 1; o < 64; o <<= 1) v += __shfl_xor(v, o);
    return v;
}
__device__ __forceinline__ float silu_f(float g) { return g * __builtin_amdgcn_rcpf(1.0f + __builtin_amdgcn_exp2f(-1.4426950408889634f * g)); }

namespace pg8 {
typedef unsigned short bf16_t;
typedef short bf16x8 __attribute__((ext_vector_type(8)));
typedef float f32x4 __attribute__((ext_vector_type(4)));
typedef unsigned u32x4 __attribute__((ext_vector_type(4)));
constexpr int BM = 256, BK = 64, HALF = 128, HTB = HALF * BK * 2, STAGE_BYTES = 8 * HTB, NXCD = 8, WGM = 8;
__host__ __device__ __forceinline__ int lds_byte(int r, int c) { const int st = (r >> 4) * 2 + (c >> 5), rr = r & 15, cc = c & 31, ob = rr * 64 + cc * 2; return st * 1024 + (ob ^ (((ob >> 9) & 1) << 5)); }
__host__ __device__ __forceinline__ void stage_rc(int b, int& R, int& C) { const int st = b / 1024, sb = b % 1024, swz = sb ^ (((sb >> 9) & 1) << 5); R = (st >> 1) * 16 + swz / 64; C = (st & 1) * 32 + (swz % 64) / 2; }
__host__ __device__ __forceinline__ int perm32(int rho) { const int n = rho >> 4, i = rho & 15; return 8 * (i >> 2) + 4 * n + (i & 3); }

struct Unit { const char* A; const char* B; int nt, pm, pn; };

template <class Map> struct GridOrder {
    int nM, nN, nwg, G, c; Map map;
    __device__ __forceinline__ void init(int nM_, int nN_, int G_, int c_, const Map& m) { nM = nM_; nN = nN_; nwg = nM * nN; G = G_; asm volatile("" : "+s"(c_)); c = c_; map = m; }
    __device__ __forceinline__ bool next(int i, Unit& u) const {
        const long L = (long)i * G + c; if (L >= nwg) return false;
        int wgid = (int)L; { const int q = nwg / NXCD, r = nwg % NXCD, xcd = wgid % NXCD, off = wgid / NXCD; wgid = (xcd < r ? xcd * (q + 1) : r * (q + 1) + (xcd - r) * q) + off; }
        const int nig = WGM * nN, gid = wgid / nig, fm = gid * WGM, gsz = (nM - fm) < WGM ? (nM - fm) : WGM;
        u.pm = fm + ((wgid % nig) % gsz); u.pn = (wgid % nig) / gsz; map.fill(u); return true;
    }
};
struct MapPlain { const char* A; const char* B; size_t astep, bstep; int nt, pm_off, pn_off;
    __device__ __forceinline__ void fill(Unit& u) const { u.A = A + (size_t)u.pm * astep; u.B = B + (size_t)u.pn * bstep; u.nt = nt; u.pm += pm_off; u.pn += pn_off; } };
struct MapF1 { const char* Wc; const char* H;
    __device__ __forceinline__ void fill(Unit& u) const { const int g = u.pm >> 1, mt = u.pm & 1; u.A = Wc + (size_t)mt * 256 * 256 * 2; u.B = H + ((size_t)u.pn * 256 * DM + g * 256) * 2; int n4 = 4; asm volatile("" : "+s"(n4)); u.nt = n4; } };
struct MapF2 { const char* S; const char* P; size_t a_tile, p_batch, p_tile; int ktshift, nt, pm_off;
    __device__ __forceinline__ void fill(Unit& u) const { const int b = u.pm >> ktshift, kt = u.pm & ((1 << ktshift) - 1); u.A = S + (size_t)kt * a_tile; u.B = P + (size_t)b * p_batch + (size_t)u.pn * p_tile; u.nt = nt; u.pm += pm_off; } };


struct EpiSwiGLU {
    static constexpr bool PERM = true;
    bf16_t* HID;
    __device__ __forceinline__ void operator()(const f32x4 (&acc)[2][2][4][2], const Unit& u, int wr, int wc, int fr, int fq, PG8_LAS unsigned char*) const {
        const int row0 = u.pm * BM + wr * 64 + fr, hc = u.pn * 128 + wc * 32 + 8 * fq;
#pragma unroll
        for (int ai = 0; ai < 2; ++ai)
#pragma unroll
            for (int m = 0; m < 4; ++m) {
                const f32x4 g0 = acc[ai][0][m][0], g1 = acc[ai][0][m][1], u0 = acc[ai][1][m][0], u1 = acc[ai][1][m][1];
                u32x4 w;
                w.x = cvt_pk_bf16(silu_f(g0[0]) * u0[0], silu_f(g0[1]) * u0[1]); w.y = cvt_pk_bf16(silu_f(g0[2]) * u0[2], silu_f(g0[3]) * u0[3]);
                w.z = cvt_pk_bf16(silu_f(g1[0]) * u1[0], silu_f(g1[1]) * u1[1]); w.w = cvt_pk_bf16(silu_f(g1[2]) * u1[2], silu_f(g1[3]) * u1[3]);
                *(u32x4*)(HID + (size_t)(row0 + ai * HALF + m * 16) * FF + hc) = w;
            }
    }
};
struct EpiResid {
    static constexpr bool PERM = false;
    const float* xin_l; const float* xin_c; float* xout_l; float* xout_c; const float* gate; float coef;
    __device__ __forceinline__ void operator()(const f32x4 (&acc)[2][2][4][2], const Unit& u, int wr, int wc, int fr, int fq, PG8_LAS unsigned char*) const {
        const bool lat = u.pm < (ML / BM); const int bp = lat ? (u.pm >> 4) : 8;
        const float* xin = lat ? xin_l + (size_t)u.pm * BM * DM : xin_c + (size_t)(u.pm - ML / BM) * BM * DM;
        float* xout = lat ? xout_l + (size_t)u.pm * BM * DM : xout_c + (size_t)(u.pm - ML / BM) * BM * DM;
        const int rl0 = wr * 64 + fr, col0 = u.pn * BM + wc * 32 + 4 * fq;
        f32x4 gv[2][2];
#pragma unroll
        for (int bj = 0; bj < 2; ++bj)
#pragma unroll
            for (int n = 0; n < 2; ++n) gv[bj][n] = *(const f32x4*)(gate + (size_t)bp * MODLD + col0 + bj * HALF + n * 16) * coef;
#pragma unroll
        for (int ai = 0; ai < 2; ++ai)
#pragma unroll
          for (int mh = 0; mh < 2; ++mh) {
            f32x4 xv[2][2][2];
#pragma unroll
            for (int mm = 0; mm < 2; ++mm) { const size_t off = (size_t)(rl0 + ai * HALF + (2 * mh + mm) * 16) * DM + col0;
#pragma unroll
                for (int bj = 0; bj < 2; ++bj)
#pragma unroll
                    for (int n = 0; n < 2; ++n) xv[mm][bj][n] = *(const f32x4*)(xin + off + bj * HALF + n * 16); }
#pragma unroll
            for (int mm = 0; mm < 2; ++mm) { const size_t off = (size_t)(rl0 + ai * HALF + (2 * mh + mm) * 16) * DM + col0;
#pragma unroll
                for (int bj = 0; bj < 2; ++bj)
#pragma unroll
                    for (int n = 0; n < 2; ++n) *(f32x4*)(xout + off + bj * HALF + n * 16) = xv[mm][bj][n] + gv[bj][n] * acc[ai][bj][2 * mh + mm][n]; }
            asm volatile("" ::: "memory"); }
    }
};
struct EpiF1 {
    static constexpr bool PERM = true;
    bf16_t* PQT; bf16_t* PQTC;
    __device__ __forceinline__ void operator()(const f32x4 (&acc)[2][2][4][2], const Unit& u, int wr, int wc, int fr, int fq, PG8_LAS unsigned char*) const {
        const int g = u.pm >> 1, mt = u.pm & 1; const bool lat = u.pn < (ML / BM);
        const int b = lat ? (u.pn >> 4) : (u.pn - ML / BM);
        const size_t ld = lat ? 8192 : 512;
        bf16_t* base = lat ? PQT + ((size_t)(b * DM + g * 256)) * 8192 + mt * SEQ + (u.pn & 15) * 256
                           : PQTC + ((size_t)(b * DM + g * 256)) * 512 + mt * CTXL;
        const int l0 = wr * 64 + fr, tc = wc * 32 + 8 * fq;
#pragma unroll
        for (int ai = 0; ai < 2; ++ai)
#pragma unroll
            for (int m = 0; m < 4; ++m) { bf16_t* rowp = base + (size_t)(l0 + ai * HALF + m * 16) * ld + tc;
#pragma unroll
                for (int bj = 0; bj < 2; ++bj) { const f32x4 v0 = acc[ai][bj][m][0], v1 = acc[ai][bj][m][1];
                    u32x4 w; w.x = cvt_pk_bf16(v0[0], v0[1]); w.y = cvt_pk_bf16(v0[2], v0[3]); w.z = cvt_pk_bf16(v1[0], v1[1]); w.w = cvt_pk_bf16(v1[2], v1[3]);
                    *(u32x4*)(rowp + bj * HALF) = w; } }
    }
};
struct EpiBf16S {
    static constexpr bool PERM = true;
    bf16_t* O; int ldc; float scale;
    __device__ __forceinline__ void operator()(const f32x4 (&acc)[2][2][4][2], const Unit& u, int wr, int wc, int fr, int fq, PG8_LAS unsigned char*) const {
        const int row0 = u.pm * BM + wr * 64 + fr, col0 = u.pn * BM + wc * 32 + 8 * fq;
#pragma unroll
        for (int ai = 0; ai < 2; ++ai)
#pragma unroll
            for (int m = 0; m < 4; ++m) { bf16_t* rowp = O + (size_t)(row0 + ai * HALF + m * 16) * ldc + col0;
#pragma unroll
                for (int bj = 0; bj < 2; ++bj) { const f32x4 v0 = acc[ai][bj][m][0] * scale, v1 = acc[ai][bj][m][1] * scale;
                    u32x4 w; w.x = cvt_pk_bf16(v0[0], v0[1]); w.y = cvt_pk_bf16(v0[2], v0[3]); w.z = cvt_pk_bf16(v1[0], v1[1]); w.w = cvt_pk_bf16(v1[2], v1[3]);
                    *(u32x4*)(rowp + bj * HALF) = w; } }
    }
};
struct EpiQKV {
    static constexpr bool PERM = true;
    bf16_t* Q; bf16_t* K; bf16_t* V; const float* tabc; const float* tabs; const float* gq; const float* gk;
    __device__ __forceinline__ void operator()(const f32x4 (&acc)[2][2][4][2], const Unit& u, int wr, int wc, int fr, int fq, PG8_LAS unsigned char* lds) const {
        const bool lat = u.pm < (ML / BM);
        const int b = lat ? (u.pm >> 4) : (u.pm - ML / BM);
        const int t0 = wc * 32 + 8 * fq;
        const int rl0 = wr * 64 + fr;
        if (u.pn >= 10) {
#pragma unroll
            for (int ai = 0; ai < 2; ++ai)
#pragma unroll
                for (int m = 0; m < 4; ++m) { const int rl = rl0 + ai * HALF + m * 16; const int kvrow = lat ? (CTXL + (u.pm & 15) * 256 + rl) : rl;
#pragma unroll
                    for (int bj = 0; bj < 2; ++bj) { const int kvh = 2 * (u.pn - 10) + bj; const f32x4 v0 = acc[ai][bj][m][0], v1 = acc[ai][bj][m][1];
                        u32x4 w; w.x = cvt_pk_bf16(v0[0], v0[1]); w.y = cvt_pk_bf16(v0[2], v0[3]); w.z = cvt_pk_bf16(v1[0], v1[1]); w.w = cvt_pk_bf16(v1[2], v1[3]);
                        *(u32x4*)(V + ((size_t)(b * NKV + kvh) * SKV + kvrow) * HD + t0) = w; } }
            return;
        }
        PG8_LAS float* T = (PG8_LAS float*)(lds + XCH_OFF);
#pragma unroll
        for (int ai = 0; ai < 2; ++ai)
#pragma unroll
            for (int m = 0; m < 4; ++m)
#pragma unroll
                for (int bj = 0; bj < 2; ++bj) { const f32x4 v0 = acc[ai][bj][m][0], v1 = acc[ai][bj][m][1];
                    float s = (v0[0] * v0[0] + v0[1] * v0[1]) + (v0[2] * v0[2] + v0[3] * v0[3]) + (v1[0] * v1[0] + v1[1] * v1[1]) + (v1[2] * v1[2] + v1[3] * v1[3]);
                    s += __shfl_xor(s, 16); s += __shfl_xor(s, 32);
                    if (fq == 0) T[(rl0 + ai * HALF + m * 16) * 8 + bj * 4 + wc] = s; }
        asm volatile("s_waitcnt lgkmcnt(0)" ::: "memory"); __builtin_amdgcn_s_barrier(); asm volatile("" ::: "memory");
        const bool isq = u.pn < 8;
        const float* gv = isq ? gq : gk;
        const f32x4 ga = *(const f32x4*)(gv + t0), gb = *(const f32x4*)(gv + t0 + 4);
        const int f0 = 16 * (wc & 1) + 4 * fq;
#pragma unroll
        for (int ai = 0; ai < 2; ++ai)
#pragma unroll
            for (int m = 0; m < 4; ++m) { const int rl = rl0 + ai * HALF + m * 16;
                f32x4 cs = (f32x4){1.f, 1.f, 1.f, 1.f}, sn = (f32x4){0.f, 0.f, 0.f, 0.f};
                if (lat) { const int s = (u.pm & 15) * 256 + rl; const int pos = (wc >> 1) ? (s & 63) : (s >> 6);
                    cs = *(const f32x4*)(tabc + pos * 32 + f0); sn = *(const f32x4*)(tabs + pos * 32 + f0); }
#pragma unroll
                for (int bj = 0; bj < 2; ++bj) {
                    const f32x4 p4 = *(const PG8_LAS f32x4*)(T + rl * 8 + bj * 4);
                    const float rstd = 1.0f / sqrtf(((p4[0] + p4[1]) + (p4[2] + p4[3])) * (1.0f / 128.0f) + EPS);
                    const f32x4 y0 = acc[ai][bj][m][0] * rstd * ga, y1 = acc[ai][bj][m][1] * rstd * gb;
                    const float a0 = y0[0] * cs[0] - y0[1] * sn[0], a1 = y0[1] * cs[0] + y0[0] * sn[0];
                    const float a2 = y0[2] * cs[1] - y0[3] * sn[1], a3 = y0[3] * cs[1] + y0[2] * sn[1];
                    const float a4 = y1[0] * cs[2] - y1[1] * sn[2], a5 = y1[1] * cs[2] + y1[0] * sn[2];
                    const float a6 = y1[2] * cs[3] - y1[3] * sn[3], a7 = y1[3] * cs[3] + y1[2] * sn[3];
                    u32x4 w; w.x = cvt_pk_bf16(a0, a1); w.y = cvt_pk_bf16(a2, a3); w.z = cvt_pk_bf16(a4, a5); w.w = cvt_pk_bf16(a6, a7);
                    if (isq) { const int h = 2 * u.pn + bj; *(u32x4*)(Q + (size_t)(u.pm * BM + rl) * DM + h * HD + t0) = w; }
                    else { const int kvh = 2 * (u.pn - 8) + bj; const int kvrow = lat ? (CTXL + (u.pm & 15) * 256 + rl) : rl;
                        *(u32x4*)(K + ((size_t)(b * NKV + kvh) * SKV + kvrow) * HD + t0) = w; }
                } }
    }
};

template <class Epi, class Sched, bool ALIGN_EPI, bool SP2>
__device__ __forceinline__ void gemm_phase(PG8_LAS unsigned char* lds, const int lda, const int ldb, const Sched& S, const Epi& E) {
    int tid_ = threadIdx.x; asm volatile("" : "+v"(tid_));
    const int tid = tid_, wid = __builtin_amdgcn_readfirstlane(tid >> 6), lane = tid & 63, wr = wid >> 2, wc = wid & 3, fr = lane & 15, fq = lane >> 4;
    unsigned voffA[2], voffB[2];
#pragma unroll
    for (int i = 0; i < 2; ++i) { int R, C; stage_rc(tid * 16 + i * 8192, R, C); const int Rb = Epi::PERM ? ((R & ~31) + perm32(R & 31)) : R;
        voffA[i] = (unsigned)(R * lda + C) * 2u; voffB[i] = (unsigned)(Rb * ldb + C) * 2u; }
    const size_t kstep = (size_t)(BK * 2);
    const size_t hstepA = (size_t)HALF * lda * 2, hstepB = (size_t)HALF * ldb * 2;
    const unsigned ldsw = (unsigned)wid * 1024u;
    const int aoff = lds_byte(wr * 64 + fr, fq * 8), boff = lds_byte(wc * 32 + fr, fq * 8);
#define PG8_SA(b, h) (((b) * 2 + (h)) * HTB)
#define PG8_SB(b, h) ((4 + (b) * 2 + (h)) * HTB)
#define PG8_STAGE(bufoff, gbase, voff) do { _Pragma("unroll") for (int _i = 0; _i < 2; ++_i) \
        __builtin_amdgcn_global_load_lds((const unsigned*)((const char*)(gbase) + (voff)[_i]), (PG8_LAS unsigned*)(lds + (bufoff) + ldsw + _i * 8192), 16, 0, 0); } while (0)
#define PG8_LDA(dst, b, h) do { _Pragma("unroll") for (int m = 0; m < 4; ++m) _Pragma("unroll") for (int k = 0; k < 2; ++k) dst[m][k] = *(const PG8_LAS bf16x8*)(lds + PG8_SA(b, h) + aoff + m * 2048 + k * 1024); } while (0)
#define PG8_LDB(dst, b, h) do { _Pragma("unroll") for (int n = 0; n < 2; ++n) _Pragma("unroll") for (int k = 0; k < 2; ++k) dst[n][k] = *(const PG8_LAS bf16x8*)(lds + PG8_SB(b, h) + boff + n * 2048 + k * 1024); } while (0)
#define PG8_MMA(ai, bj, At, Bt) do { __builtin_amdgcn_s_setprio(1); _Pragma("unroll") for (int m = 0; m < 4; ++m) _Pragma("unroll") for (int n = 0; n < 2; ++n) _Pragma("unroll") for (int k = 0; k < 2; ++k) \
        acc[ai][bj][m][n] = __builtin_amdgcn_mfma_f32_16x16x32_bf16(Bt[n][k], At[m][k], acc[ai][bj][m][n], 0, 0, 0); __builtin_amdgcn_s_setprio(0); } while (0)
#define PG8_WAIT_V(n) asm volatile("s_waitcnt vmcnt(" #n ")" ::: "memory")
#define PG8_WAIT_L(n) asm volatile("s_waitcnt lgkmcnt(" #n ")" ::: "memory")
#define PG8_BAR __builtin_amdgcn_s_barrier()
#define PG8_SCHED __builtin_amdgcn_sched_barrier(0)
    Unit cur, nxt; int ui = 0;
    if (!S.next(0, cur)) return;
    f32x4 acc[2][2][4][2];
#pragma unroll
    for (int a = 0; a < 2; ++a)
#pragma unroll
        for (int b = 0; b < 2; ++b)
#pragma unroll
            for (int m = 0; m < 4; ++m)
#pragma unroll
                for (int n = 0; n < 2; ++n) acc[a][b][m][n] = (f32x4){0.f, 0.f, 0.f, 0.f};
    bf16x8 At[4][2], B0[2][2], B1[2][2];
    const char* cA = cur.A; const char* cB = cur.B;
    if constexpr (SP2) {
        PG8_STAGE(PG8_SB(0, 0), cB, voffB); PG8_STAGE(PG8_SB(0, 1), cB + hstepB, voffB); PG8_STAGE(PG8_SA(0, 0), cA, voffA); PG8_STAGE(PG8_SA(0, 1), cA + hstepA, voffA);
        if (wr == 1) PG8_BAR;
        PG8_WAIT_V(2); PG8_BAR;
        PG8_STAGE(PG8_SB(1, 0), cB + kstep, voffB); PG8_STAGE(PG8_SA(1, 0), cA + kstep, voffA); PG8_STAGE(PG8_SB(1, 1), cB + hstepB + kstep, voffB);
        PG8_WAIT_V(6); PG8_BAR;
    } else {
        PG8_STAGE(PG8_SB(0, 0), cB, voffB); PG8_STAGE(PG8_SA(0, 0), cA, voffA); PG8_STAGE(PG8_SB(0, 1), cB + hstepB, voffB); PG8_STAGE(PG8_SA(0, 1), cA + hstepA, voffA);
        if (wr == 1) PG8_BAR;
        PG8_WAIT_V(4); PG8_BAR;
        PG8_STAGE(PG8_SB(1, 0), cB + kstep, voffB); PG8_STAGE(PG8_SA(1, 0), cA + kstep, voffA); PG8_STAGE(PG8_SB(1, 1), cB + hstepB + kstep, voffB);
        PG8_WAIT_V(6); PG8_BAR;
    }
    for (;;) {
        const bool has_next = S.next(ui + 1, nxt);
        const char* nA = has_next ? nxt.A : cA; const char* nB = has_next ? nxt.B : cB;
        const int nt = cur.nt;
        for (int t = 0; t < nt; t += 2) {
            const bool last = (t == nt - 2);
            const char* a1 = cA + (size_t)(t + 1) * kstep;
            const char* a2 = last ? nA : cA + (size_t)(t + 2) * kstep; const char* b2 = last ? nB : cB + (size_t)(t + 2) * kstep;
            const char* a3 = a2 + kstep; const char* b3 = b2 + kstep;
            if constexpr (SP2) {
            PG8_LDB(B0, 0, 0); PG8_LDB(B1, 0, 1); PG8_SCHED; PG8_LDA(At, 0, 0); PG8_STAGE(PG8_SA(1, 1), a1 + hstepA, voffA);
            PG8_WAIT_V(8); PG8_WAIT_L(0); PG8_BAR; PG8_MMA(0, 0, At, B0); PG8_MMA(0, 1, At, B1); PG8_BAR; PG8_SCHED;
            PG8_LDA(At, 0, 1); PG8_STAGE(PG8_SB(0, 0), b2, voffB); PG8_STAGE(PG8_SB(0, 1), b2 + hstepB, voffB); PG8_STAGE(PG8_SA(0, 0), a2, voffA);
            PG8_WAIT_V(8); PG8_WAIT_L(0); PG8_BAR; PG8_MMA(1, 0, At, B0); PG8_MMA(1, 1, At, B1); PG8_BAR; PG8_SCHED;
            PG8_LDB(B0, 1, 0); PG8_LDB(B1, 1, 1); PG8_SCHED; PG8_LDA(At, 1, 0); PG8_STAGE(PG8_SA(0, 1), a2 + hstepA, voffA);
            PG8_WAIT_V(8); PG8_WAIT_L(0); PG8_BAR; PG8_MMA(0, 0, At, B0); PG8_MMA(0, 1, At, B1); PG8_BAR; PG8_SCHED;
            PG8_LDA(At, 1, 1); PG8_STAGE(PG8_SB(1, 0), b3, voffB); PG8_STAGE(PG8_SB(1, 1), b3 + hstepB, voffB); PG8_STAGE(PG8_SA(1, 0), a3, voffA);
            PG8_WAIT_V(8); PG8_WAIT_L(0); PG8_BAR; PG8_MMA(1, 0, At, B0); PG8_MMA(1, 1, At, B1); PG8_BAR; PG8_SCHED;
            } else {
            PG8_LDB(B0, 0, 0); PG8_SCHED; PG8_LDA(At, 0, 0); PG8_STAGE(PG8_SA(1, 1), a1 + hstepA, voffA);
            PG8_WAIT_L(8); PG8_BAR; PG8_WAIT_L(0); PG8_MMA(0, 0, At, B0); PG8_BAR; PG8_SCHED;
            PG8_LDB(B1, 0, 1); PG8_STAGE(PG8_SB(0, 0), b2, voffB);
            PG8_BAR; PG8_WAIT_L(0); PG8_MMA(0, 1, At, B1); PG8_BAR;
            PG8_LDA(At, 0, 1); PG8_STAGE(PG8_SA(0, 0), a2, voffA);
            PG8_BAR; PG8_WAIT_L(0); PG8_MMA(1, 0, At, B0); PG8_BAR; PG8_SCHED;
            PG8_STAGE(PG8_SB(0, 1), b2 + hstepB, voffB);
            PG8_WAIT_V(6); PG8_BAR; PG8_MMA(1, 1, At, B1); PG8_BAR;
            PG8_LDB(B0, 1, 0); PG8_SCHED; PG8_LDA(At, 1, 0); PG8_STAGE(PG8_SA(0, 1), a2 + hstepA, voffA);
            PG8_WAIT_L(8); PG8_BAR; PG8_WAIT_L(0); PG8_MMA(0, 0, At, B0); PG8_BAR; PG8_SCHED;
            PG8_LDB(B1, 1, 1); PG8_STAGE(PG8_SB(1, 0), b3, voffB);
            PG8_BAR; PG8_WAIT_L(0); PG8_MMA(0, 1, At, B1); PG8_BAR;
            PG8_LDA(At, 1, 1); PG8_STAGE(PG8_SA(1, 0), a3, voffA);
            PG8_BAR; PG8_WAIT_L(0); PG8_MMA(1, 0, At, B0); PG8_BAR; PG8_SCHED;
            PG8_STAGE(PG8_SB(1, 1), b3 + hstepB, voffB);
            PG8_WAIT_V(6); PG8_BAR; PG8_MMA(1, 1, At, B1); PG8_BAR;
            }
        }
        if constexpr (ALIGN_EPI) { if (wr == 0) PG8_BAR; }
        E(acc, cur, wr, wc, fr, fq, lds);
        if (!has_next) break;
#pragma unroll
        for (int a = 0; a < 2; ++a)
#pragma unroll
            for (int b = 0; b < 2; ++b)
#pragma unroll
                for (int m = 0; m < 4; ++m)
#pragma unroll
                    for (int n = 0; n < 2; ++n) acc[a][b][m][n] = (f32x4){0.f, 0.f, 0.f, 0.f};
        cur = nxt; cA = nA; cB = nB; ++ui;
        if constexpr (ALIGN_EPI) { if (wr == 1) PG8_BAR; }
    }
    PG8_WAIT_V(0);
    if constexpr (!ALIGN_EPI) { if (wr == 0) PG8_BAR; }
    PG8_BAR;
#undef PG8_SA
#undef PG8_SB
#undef PG8_STAGE
#undef PG8_LDA
#undef PG8_LDB
#undef PG8_MMA
#undef PG8_WAIT_V
#undef PG8_WAIT_L
#undef PG8_BAR
#undef PG8_SCHED
}
}

namespace att {
using bf16x8 = __attribute__((ext_vector_type(8))) short;
using s16x4  = __attribute__((ext_vector_type(4))) short;
using f32x16 = __attribute__((ext_vector_type(16))) float;
using u32x4  = __attribute__((ext_vector_type(4))) unsigned;
constexpr int D = 128, NW = 8, QBLK = 32, KVBLK = 64;
constexpr float SCALE = 0.088388347648318440f;
constexpr float THR = 8.f;
#ifndef ATTN_SDEPTH
#define ATTN_SDEPTH 1
#endif
constexpr int SDEPTH = ATTN_SDEPTH;
constexpr int LDQ = DM, LDK = HD, LDO = DM;
constexpr size_t SHM_V = KVBLK * D * 2, SHM_K = KVBLK * D * 2, SHM_ATTN = 2 * SHM_V + 2 * SHM_K + NW * 64 * 4;
#define KSWZ(row, colB) ((row) * 256 + ((colB) ^ (((row) & 7) << 4)))
#define SBAR() __builtin_amdgcn_sched_barrier(0)
__device__ __forceinline__ int crow(int r, int hi) { return (r & 3) + 8 * (r >> 2) + 4 * hi; }
__device__ __forceinline__ unsigned cvtpk(float lo, float hi) { unsigned r; asm volatile("v_cvt_pk_bf16_f32 %0, %1, %2" : "=v"(r) : "v"(lo), "v"(hi)); return r; }
__device__ __forceinline__ void partialSM(f32x16& p0, f32x16& p1, float& m_reg, float& mn, float& alpha) {
  constexpr float C = SCALE * 1.4426950408889634f;
  float pmax = p0[0]; for (int r = 1; r < 16; ++r) pmax = fmaxf(pmax, p0[r]); for (int r = 0; r < 16; ++r) pmax = fmaxf(pmax, p1[r]);
  { auto rr = __builtin_amdgcn_permlane32_swap(__float_as_uint(pmax), __float_as_uint(pmax), false, false);
    pmax = fmaxf(__uint_as_float(rr[0]), __uint_as_float(rr[1])); }
  if (__builtin_expect(__all(pmax - m_reg <= THR / SCALE), 1)) { mn = m_reg; alpha = 1.f; }
  else { mn = fmaxf(m_reg, pmax); alpha = __builtin_amdgcn_exp2f((m_reg - mn) * C); m_reg = mn; }
  float mnC = -mn * C;
  for (int r = 0; r < 16; ++r) p0[r] = fmaf(p0[r], C, mnC); for (int r = 0; r < 16; ++r) p1[r] = fmaf(p1[r], C, mnC);
  for (int r = 0; r < 16; ++r) p0[r] = __builtin_amdgcn_exp2f(p0[r]);
}
__device__ __forceinline__ void finishSM(f32x16& p0, f32x16& p1, float alpha, float& l_reg, bf16x8& pa0, bf16x8& pa1, bf16x8& pa2, bf16x8& pa3) {
  for (int r = 0; r < 16; ++r) p1[r] = __builtin_amdgcn_exp2f(p1[r]);
  float ps = 0; for (int r = 0; r < 16; ++r) ps += p0[r]; for (int r = 0; r < 16; ++r) ps += p1[r];
  { auto rr = __builtin_amdgcn_permlane32_swap(__float_as_uint(ps), __float_as_uint(ps), false, false);
    ps = __uint_as_float(rr[0]) + __uint_as_float(rr[1]); }
  l_reg = l_reg * alpha + ps;
#define PK4(P, BASE, OUT) do { unsigned a0 = cvtpk(P[BASE + 0], P[BASE + 1]), a1 = cvtpk(P[BASE + 2], P[BASE + 3]);   \
    unsigned b0 = cvtpk(P[BASE + 4], P[BASE + 5]), b1 = cvtpk(P[BASE + 6], P[BASE + 7]);                              \
    auto r0 = __builtin_amdgcn_permlane32_swap(a0, b0, false, false); auto r1 = __builtin_amdgcn_permlane32_swap(a1, b1, false, false); \
    u32x4 w = {r0[0], r1[0], r0[1], r1[1]}; OUT = *reinterpret_cast<bf16x8*>(&w); } while (0)
  PK4(p0, 0, pa0); PK4(p0, 8, pa1); PK4(p1, 0, pa2); PK4(p1, 8, pa3);
#undef PK4
}
__device__ __forceinline__ void qkt(f32x16& p0, f32x16& p1, const bf16* Ks, const bf16x8* qr, int r32, int hi) {
  p0 = f32x16{}; p1 = f32x16{};
  for (int d0 = 0; d0 < 8; ++d0) { int cb = (d0 * 16 + hi * 8) * 2;
    bf16x8 b0 = *reinterpret_cast<const bf16x8*>((const char*)Ks + KSWZ(r32, cb));
    bf16x8 b1 = *reinterpret_cast<const bf16x8*>((const char*)Ks + KSWZ(32 + r32, cb));
    p0 = __builtin_amdgcn_mfma_f32_32x32x16_bf16(b0, qr[d0], p0, 0, 0, 0);
    p1 = __builtin_amdgcn_mfma_f32_32x32x16_bf16(b1, qr[d0], p1, 0, 0, 0); }
}
__device__ __forceinline__ int v_st(int k, int c) { const int kk = (k & ~0xC) | ((k & 4) << 1) | ((k & 8) >> 1); return ((kk >> 3) * 4 + (c >> 5)) * 512 + ((kk & 7) * 32 + (c & 31)) * 2; }
__device__ __forceinline__ int v_rd_base(int lane) { return ((lane & 3) << 3) | (((lane >> 2) & 3) << 6) | (((lane >> 4) & 1) << 5) | (((lane >> 5) & 1) << 8); }
constexpr int v_rd_off(int d0, int ks, int half) { return d0 * 512 + ks * 4096 + half * 2048; }
template <int OFF> __device__ __forceinline__ s16x4 tr_read(int vb) {
  s16x4 r; asm volatile("ds_read_b64_tr_b16 %0, %1 offset:%2" : "=&v"(r) : "v"(vb), "i"(OFF) : "memory"); return r;
}
template <int D0> __device__ __forceinline__ void pv_one(f32x16& od, int vb, bf16x8 pa0, bf16x8 pa1, bf16x8 pa2, bf16x8 pa3) {
  const s16x4 l0 = tr_read<v_rd_off(D0, 0, 0)>(vb), h0 = tr_read<v_rd_off(D0, 0, 1)>(vb), l1 = tr_read<v_rd_off(D0, 1, 0)>(vb), h1 = tr_read<v_rd_off(D0, 1, 1)>(vb);
  const s16x4 l2 = tr_read<v_rd_off(D0, 2, 0)>(vb), h2 = tr_read<v_rd_off(D0, 2, 1)>(vb), l3 = tr_read<v_rd_off(D0, 3, 0)>(vb), h3 = tr_read<v_rd_off(D0, 3, 1)>(vb);
  asm volatile("s_waitcnt lgkmcnt(0)" ::: "memory"); SBAR();
#define PK(L, H) (bf16x8){L[0], L[1], L[2], L[3], H[0], H[1], H[2], H[3]}
  od = __builtin_amdgcn_mfma_f32_32x32x16_bf16(pa0, PK(l0, h0), od, 0, 0, 0);
  od = __builtin_amdgcn_mfma_f32_32x32x16_bf16(pa1, PK(l1, h1), od, 0, 0, 0);
  od = __builtin_amdgcn_mfma_f32_32x32x16_bf16(pa2, PK(l2, h2), od, 0, 0, 0);
  od = __builtin_amdgcn_mfma_f32_32x32x16_bf16(pa3, PK(l3, h3), od, 0, 0, 0);
#undef PK
}
__device__ __forceinline__ void pv_d0(f32x16* o, int vb, bf16x8 pa0, bf16x8 pa1, bf16x8 pa2, bf16x8 pa3) {
  pv_one<0>(o[0], vb, pa0, pa1, pa2, pa3); pv_one<1>(o[1], vb, pa0, pa1, pa2, pa3); pv_one<2>(o[2], vb, pa0, pa1, pa2, pa3); pv_one<3>(o[3], vb, pa0, pa1, pa2, pa3);
}
__device__ __forceinline__ void attn_dense_body(const bf16* __restrict__ Qb, const bf16* __restrict__ Kh, const bf16* __restrict__ Vh, bf16* __restrict__ Ob, int seq, char* lds) {
  int tid_ = threadIdx.x; asm volatile("" : "+v"(tid_));
  const int tid = tid_, wid = tid >> 6, lane = tid & 63, r32 = lane & 31, hi = lane >> 5;
  bf16* V_lds = (bf16*)lds; bf16* K_lds = (bf16*)(lds + 2 * SHM_V);
  float* ws = (float*)(lds + 2 * SHM_V + 2 * SHM_K) + wid * 64; float* li_l = ws; float* al_l = ws + 32;
  float m_reg = -1e30f, l_reg = 0; f32x16 o[4] = {}; bf16x8 qr[8];
  const bf16* Qw = Qb + (long)(wid * QBLK + r32) * LDQ + hi * 8;
#pragma unroll
  for (int d0 = 0; d0 < 8; ++d0) qr[d0] = *reinterpret_cast<const bf16x8*>(Qw + d0 * 16);
  const int sr = tid >> 4, sc = (tid & 15) * 8, vst0 = v_st(sr, sc), vst1 = v_st(32 + sr, sc);
  const int vb0 = (int)(uintptr_t)V_lds + v_rd_base(lane);
  struct { bf16x8 vs0, vs1, ks0, ks1; } sr_[SDEPTH];
#define LD8(p) (*reinterpret_cast<const bf16x8*>(p))
#define SLOAD(i, k0) do { sr_[i].vs0 = LD8(&Vh[(long)((k0) + sr) * LDK + sc]); sr_[i].vs1 = LD8(&Vh[(long)((k0) + 32 + sr) * LDK + sc]); \
    sr_[i].ks0 = LD8(&Kh[(long)((k0) + sr) * LDK + sc]); sr_[i].ks1 = LD8(&Kh[(long)((k0) + 32 + sr) * LDK + sc]); } while (0)
#define SWRITE(b, i) do { *(bf16x8*)((char*)V_lds + (b) * SHM_V + vst0) = sr_[i].vs0;          \
    *(bf16x8*)((char*)V_lds + (b) * SHM_V + vst1) = sr_[i].vs1; int kc = sc * 2;               \
    *(bf16x8*)((char*)K_lds + (b) * SHM_K + KSWZ(sr, kc)) = sr_[i].ks0;                       \
    *(bf16x8*)((char*)K_lds + (b) * SHM_K + KSWZ(32 + sr, kc)) = sr_[i].ks1; } while (0)
#define SWAIT() do { if constexpr (SDEPTH == 2) asm volatile("s_waitcnt vmcnt(4)" ::: "memory"); else asm volatile("s_waitcnt vmcnt(0)" ::: "memory"); } while (0)
#define RESC(a) do { if (__any((a) < 1.f)) { if (hi == 0) al_l[r32] = (a); asm volatile("s_waitcnt lgkmcnt(0)" ::: "memory"); \
    for (int d = 0; d < 4; ++d) for (int r = 0; r < 16; ++r) o[d][r] *= al_l[crow(r, hi)]; } } while (0)
  f32x16 pA0, pA1, pB0, pB1; float mnA, mnB, alA, alB; bf16x8 pa0, pa1, pa2, pa3; const int NT = seq / KVBLK;
  constexpr int SE = 0, SO = SDEPTH - 1;
  SLOAD(SE, 0); asm volatile("s_waitcnt vmcnt(0)" ::: "memory"); SWRITE(0, SE); __syncthreads();
  qkt(pA0, pA1, K_lds, qr, r32, hi); partialSM(pA0, pA1, m_reg, mnA, alA);
  SLOAD(SO, KVBLK); if constexpr (SDEPTH == 2) { if (2 < NT) SLOAD(SE, 2 * KVBLK); }
  SWAIT(); SWRITE(1, SO); __syncthreads();
  for (int j = 1; j + 1 < NT; j += 2) {
    SBAR(); qkt(pB0, pB1, (bf16*)((char*)K_lds + SHM_K), qr, r32, hi);
    finishSM(pA0, pA1, alA, l_reg, pa0, pa1, pa2, pa3); SBAR();
    SLOAD(SO, (j + SDEPTH) * KVBLK); SBAR();
    pv_d0(o, vb0, pa0, pa1, pa2, pa3); partialSM(pB0, pB1, m_reg, mnB, alB);
    __syncthreads(); SWAIT(); SWRITE(0, SE);
    RESC(alB); __syncthreads();
    SBAR(); qkt(pA0, pA1, K_lds, qr, r32, hi);
    finishSM(pB0, pB1, alB, l_reg, pa0, pa1, pa2, pa3); SBAR();
    if (SDEPTH == 1 || j + 3 < NT) SLOAD(SE, (j + 1 + SDEPTH) * KVBLK); SBAR();
    pv_d0(o, vb0 + (int)SHM_V, pa0, pa1, pa2, pa3); partialSM(pA0, pA1, m_reg, mnA, alA);
    __syncthreads(); SWAIT(); SWRITE(1, SO);
    RESC(alA); __syncthreads();
  }
  SBAR(); qkt(pB0, pB1, (bf16*)((char*)K_lds + SHM_K), qr, r32, hi);
  finishSM(pA0, pA1, alA, l_reg, pa0, pa1, pa2, pa3); SBAR();
  pv_d0(o, vb0, pa0, pa1, pa2, pa3); partialSM(pB0, pB1, m_reg, mnB, alB);
  __syncthreads(); RESC(alB);
  finishSM(pB0, pB1, alB, l_reg, pa0, pa1, pa2, pa3); SBAR();
  pv_d0(o, vb0 + (int)SHM_V, pa0, pa1, pa2, pa3);
  if (hi == 0) li_l[r32] = l_reg; asm volatile("s_waitcnt lgkmcnt(0)" ::: "memory");
  float rli[16];
#pragma unroll
  for (int r = 0; r < 16; ++r) rli[r] = __builtin_amdgcn_rcpf(li_l[crow(r, hi)]);
  bf16* Ow = Ob + (long)(wid * QBLK) * LDO;
#pragma unroll
  for (int r = 0; r < 16; ++r) { int orow = crow(r, hi);
    for (int d0 = 0; d0 < 4; ++d0) Ow[(long)orow * LDO + d0 * 32 + r32] = (bf16)f2bf(o[d0][r] * rli[r]); }
  __syncthreads();
#undef LD8
#undef SLOAD
#undef SWRITE
#undef SWAIT
#undef RESC
}
}

#define XB_TMO      128
#define XB_XCNT(j)  (256  + 64 * (j))
#define XB_XSUB(j)  (1280 + 64 * (j))
#define XB_XGEN(j)  (2304 + 64 * (j))
#define XB_TOP      3328
#define XB_TOPGEN   3392
#define XCD_BAR_WORDS 3456
#define XB_SPIN_CAP (1u << 18)
__device__ __forceinline__ unsigned xb_ld(unsigned* p)              { return __hip_atomic_load(p, __ATOMIC_RELAXED, __HIP_MEMORY_SCOPE_AGENT); }
__device__ __forceinline__ unsigned xb_add(unsigned* p, unsigned v) { return __hip_atomic_fetch_add(p, v, __ATOMIC_RELAXED, __HIP_MEMORY_SCOPE_AGENT); }
__device__ __forceinline__ unsigned xb_xcc_id() { return (unsigned)__builtin_amdgcn_s_getreg((3 << 11) | 20) & 0xFu; }
#define XB_SPIN(cond, bar) do { unsigned _sp = 0; while (cond) { __builtin_amdgcn_s_sleep(1); \
    if ((++_sp & 255u) == 0u) { if (xb_ld(&(bar)[XB_TMO])) break; if (_sp > XB_SPIN_CAP) { atomicAdd(&(bar)[XB_TMO], 1u); break; } } } } while (0)
struct XcdBarrier { unsigned* bar; unsigned x; volatile LAS unsigned* st; };
__device__ __forceinline__ XcdBarrier xcd_barrier_post(unsigned* bar, volatile LAS unsigned* st) {
    XcdBarrier b; b.bar = bar; b.x = xb_xcc_id(); b.st = st;
    if (threadIdx.x == 0) (void)xb_add(&bar[XB_XCNT(b.x)], 1u);
    return b;
}
__device__ __forceinline__ void xcd_barrier_complete(unsigned* bar, unsigned x, unsigned& nloc, unsigned& nx) {
    const unsigned G = gridDim.x * gridDim.y * gridDim.z;
    unsigned sum, cnt, mine, sp = 0u;
    for (;;) {
        sum = 0u; cnt = 0u; mine = 0u;
#pragma unroll
        for (unsigned j = 0; j < 16; ++j) { const unsigned c = xb_ld(&bar[XB_XCNT(j)]); sum += c; cnt += (c > 0u) ? 1u : 0u; mine = (j == x) ? c : mine; }
        if (sum == G) break;
        __builtin_amdgcn_s_sleep(1);
        if ((++sp & 255u) == 0u) { if (xb_ld(&bar[XB_TMO])) break; if (sp > XB_SPIN_CAP) { atomicAdd(&bar[XB_TMO], 1u); break; } }
    }
    nloc = mine > 0u ? mine : 1u; nx = cnt > 0u ? cnt : 1u;
}
__device__ __forceinline__ void xcd_barrier(const XcdBarrier& b) {
    asm volatile("s_waitcnt vmcnt(0)" ::: "memory");
    __syncthreads();
    if (threadIdx.x == 0) {
        unsigned* bar = b.bar;
        __builtin_amdgcn_s_waitcnt(0);
        unsigned nloc = b.st[0], nx = b.st[1];
        if (nloc == 0u) { xcd_barrier_complete(bar, b.x, nloc, nx); b.st[0] = nloc; b.st[1] = nx; }
        const unsigned old = xb_add(&bar[XB_XSUB(b.x)], 1u);
        const unsigned gen = old / nloc;
        if (old + 1u == (gen + 1u) * nloc) {
            __builtin_amdgcn_fence(__ATOMIC_RELEASE, "agent");
            asm volatile("s_waitcnt vmcnt(0)" ::: "memory");
            const unsigned og = xb_add(&bar[XB_TOP], 1u);
            const unsigned tg = og / nx;
            if (og + 1u == (tg + 1u) * nx) xb_add(&bar[XB_TOPGEN], 1u);
            else XB_SPIN(xb_ld(&bar[XB_TOPGEN]) == tg, bar);
            __builtin_amdgcn_fence(__ATOMIC_ACQUIRE, "agent");
            xb_add(&bar[XB_XGEN(b.x)], 1u);
            asm volatile("s_waitcnt vmcnt(0)" ::: "memory");
        } else {
            XB_SPIN(xb_ld(&bar[XB_XGEN(b.x)]) == gen, bar);
            __builtin_amdgcn_fence(__ATOMIC_ACQUIRE, "agent");
            asm volatile("s_waitcnt vmcnt(0)" ::: "memory");
        }
    }
    __syncthreads();
}

template <int MODE> __device__ __forceinline__ int drow(int n) {
    if (MODE == 1) { const bool up = n >= FF; const int i = up ? n - FF : n; return (i >> 7) * 256 + (up ? 128 : 0) + (i & 127); }
    if (MODE == 2) { if (n >= 2560) return n; const int d = n & 127, a = d >> 6, w = d & 63, half = w >> 5, f = w & 31; return (n & ~127) + 2 * (a * 32 + f) + half; }
    return n;
}
template <int MODE> __device__ __forceinline__ void transpose_item(const float* W, int K, int N, bf16* WT, LAS float* scr, int item, int lane) {
    const int nblk = N / 32, kb = item / nblk, nb = item % nblk, k0 = 64 * kb, n0 = 32 * nb;
#pragma unroll 8
    for (int i = 0; i < 32; ++i) { const int kk = 2 * i + (lane >> 5); scr[kk * 33 + (lane & 31)] = W[(size_t)(k0 + kk) * N + n0 + (lane & 31)]; }
    LDS_WAIT(); asm volatile("" ::: "memory");
    const int c = lane & 7;
#pragma unroll
    for (int j = 0; j < 4; ++j) { const int n = (lane >> 3) + 8 * j; const LAS float* s = scr + (8 * c) * 33 + n;
        v4u o; o.x = pk2(s[0 * 33], s[1 * 33]); o.y = pk2(s[2 * 33], s[3 * 33]); o.z = pk2(s[4 * 33], s[5 * 33]); o.w = pk2(s[6 * 33], s[7 * 33]);
        *(GAS v4u*)(WT + (size_t)drow<MODE>(n0 + n) * K + k0 + 8 * c) = o; }
    LDS_WAIT(); asm volatile("" ::: "memory");
}
__device__ __forceinline__ void modulate_rows(const float* xl, const float* xc, int nrows, const float* ng, const float* shift, const float* scale, bf16* H, int gw, int NGW, int lane) {
    for (int row = gw; row < nrows; row += NGW) {
        const bool lat = row < ML; const int bp = lat ? (row >> 12) : 8;
        const float* src = lat ? xl + (size_t)row * DM : xc + (size_t)(row - ML) * DM;
        const GAS f32x4* xr = (const GAS f32x4*)src + lane;
        f32x4 v[8]; float s = 0.f;
#pragma unroll
        for (int j = 0; j < 8; ++j) { v[j] = xr[64 * j]; s += (v[j].x * v[j].x + v[j].y * v[j].y) + (v[j].z * v[j].z + v[j].w * v[j].w); }
        const float rstd = 1.0f / sqrtf(wave_sum(s) * (1.0f / DM) + EPS);
        const GAS f32x4* g4 = (const GAS f32x4*)ng + lane; const GAS f32x4* sh4 = (const GAS f32x4*)(shift + (size_t)bp * MODLD) + lane; const GAS f32x4* sc4 = (const GAS f32x4*)(scale + (size_t)bp * MODLD) + lane;
        GAS v2u* o8 = (GAS v2u*)(H + (size_t)row * DM) + lane;
#pragma unroll
        for (int j = 0; j < 8; ++j) { const f32x4 g = g4[64 * j], sh = sh4[64 * j], sc = sc4[64 * j];
            const f32x4 y = v[j] * rstd * g * (sc + 1.0f) + sh;
            v2u w; w.x = pk2(y.x, y.y); w.y = pk2(y.z, y.w); o8[64 * j] = w; }
    }
}

struct Ctx { LAS unsigned char* lds; char* lds_gen; unsigned char* ws; int G, bx, vcu, gw, NGW, lane, lo, hi;
    const float* x_in; const float* ctx_in; const float* norm_g; float* X; float* XC; const float* MOD; const float* TABC; const float* TABS; const float* GQ; const float* GK; };
#define IN() (c.lo <= ph && ph < c.hi)
#define SEAM() do { if (c.lo <= ph && ph + 1 < c.hi) xcd_barrier(bar); ++ph; } while (0)
template <int f> __device__ __forceinline__ void macaron_step(const Ctx& c, const XcdBarrier& bar, int& ph) {
    LAS unsigned char* lds = c.lds; unsigned char* ws = c.ws; const int G = c.G, bx = c.bx, vcu = c.vcu, gw = c.gw, NGW = c.NGW, lane = c.lane;
    const float* x_in = c.x_in; const float* ctx_in = c.ctx_in; const float* norm_g = c.norm_g; float* X = c.X; float* XC = c.XC; const float* MOD = c.MOD;
    const float* TABC = c.TABC; const float* TABS = c.TABS; const float* GQ = c.GQ; const float* GK = c.GK;
    bf16* WCH = (bf16*)(ws + WS_WC); bf16* SEQC = WCH + 512 * 256; bf16* SEQM = (bf16*)(ws + WS_SEQ);
    bf16* WFO = (bf16*)(ws + WS_WFO); bf16* WQKV = (bf16*)(ws + WS_WQKV); bf16* WAO = (bf16*)(ws + WS_WAO);
    bf16* H = (bf16*)(ws + WS_H); bf16* HID = (bf16*)(ws + WS_HID); bf16* PQT = (bf16*)(ws + WS_PQT); bf16* PQTC = (bf16*)(ws + WS_PQTC);
    bf16* FB = (bf16*)(ws + WS_F); bf16* QB = (bf16*)(ws + WS_Q); bf16* KB = (bf16*)(ws + WS_K); bf16* VB = (bf16*)(ws + WS_V); bf16* OB = (bf16*)(ws + WS_O);
    (void)vcu; (void)WCH; (void)SEQC; (void)SEQM; (void)WFO; (void)WQKV; (void)WAO; (void)PQT; (void)PQTC; (void)FB; (void)QB; (void)KB; (void)VB; (void)OB; (void)TABC; (void)TABS; (void)GQ; (void)GK; (void)x_in; (void)ctx_in;
    const int ly = f >> 1, sub = f & 1;
    const float* modl = MOD + (size_t)ly * 9 * MODLD;
    const float* xs_l = (f == 0) ? x_in : X; const float* xs_c = (f == 0) ? ctx_in : XC;
    const int nMf = (f == 3) ? ML / 256 : MA / 256;
    if (IN()) modulate_rows(xs_l, xs_c, nMf * 256, norm_g + (size_t)(ly * 3 + (sub ? 2 : 0)) * DM, modl + (sub ? 6 : 0) * DM, modl + (sub ? 7 : 1) * DM, H, gw, NGW, lane);
    SEAM();
    if (IN()) {
        pg8::MapPlain mp{(const char*)H, (const char*)(ws + WS_WIN + (size_t)f * WIN_BYTES), (size_t)256 * DM * 2, (size_t)256 * DM * 2, DM / 64, 0, 0};
        pg8::GridOrder<pg8::MapPlain> S; S.init(nMf, 2 * FF / 256, G, bx, mp);
        pg8::EpiSwiGLU E{HID};
        pg8::gemm_phase<pg8::EpiSwiGLU, pg8::GridOrder<pg8::MapPlain>, true, true>(lds, DM, DM, S, E);
    }
    SEAM();
    if (IN()) {
        pg8::MapPlain mp{(const char*)HID, (const char*)(ws + WS_WOUT + (size_t)f * WOUT_BYTES), (size_t)256 * FF * 2, (size_t)256 * FF * 2, FF / 64, 0, 0};
        pg8::GridOrder<pg8::MapPlain> S; S.init(nMf, DM / 256, G, bx, mp);
        pg8::EpiResid E{xs_l, xs_c, X, XC, modl + (sub ? 8 : 2) * DM, 0.5f};
        pg8::gemm_phase<pg8::EpiResid, pg8::GridOrder<pg8::MapPlain>, true, true>(lds, FF, FF, S, E);
    }
    SEAM();
    if constexpr (f == 0) {
        if (IN()) modulate_rows(X, XC, MA, norm_g + (size_t)(ly * 3 + 1) * DM, modl + 3 * DM, modl + 4 * DM, H, gw, NGW, lane);
        SEAM();
        if (IN()) {
            pg8::MapF1 mp{(const char*)WCH, (const char*)H};
            pg8::GridOrder<pg8::MapF1> S; S.init(16, MA / 256, G, bx, mp);
            pg8::EpiF1 E{PQT, PQTC};
            pg8::gemm_phase<pg8::EpiF1, pg8::GridOrder<pg8::MapF1>, true, true>(lds, 256, DM, S, E);
        }
        SEAM();
        if (IN()) {
            for (int part = 0; part < 2; ++part) {
                pg8::MapF2 mp = part == 0 ? pg8::MapF2{(const char*)SEQM, (const char*)PQT, (size_t)256 * 8192 * 2, (size_t)DM * 8192 * 2, (size_t)256 * 8192 * 2, 4, 8192 / 64, 0}
                                          : pg8::MapF2{(const char*)SEQC, (const char*)PQTC, (size_t)0, (size_t)DM * 512 * 2, (size_t)256 * 512 * 2, 0, 512 / 64, ML / 256};
                pg8::GridOrder<pg8::MapF2> S; S.init(part == 0 ? ML / 256 : NB, DM / 256, G, bx, mp);
                pg8::EpiBf16S E{FB, DM, part == 0 ? (1.0f / 1024.0f) : (1.0f / 256.0f)};
                const int ld = part == 0 ? 8192 : 512;
                pg8::gemm_phase<pg8::EpiBf16S, pg8::GridOrder<pg8::MapF2>, true, true>(lds, ld, ld, S, E);
            }
        }
        SEAM();
        if (IN()) {
            pg8::MapPlain mp{(const char*)FB, (const char*)WFO, (size_t)256 * DM * 2, (size_t)256 * DM * 2, DM / 64, 0, 0};
            pg8::GridOrder<pg8::MapPlain> S; S.init(MA / 256, DM / 256, G, bx, mp);
            pg8::EpiResid E{X, XC, X, XC, modl + 5 * DM, 1.0f};
            pg8::gemm_phase<pg8::EpiResid, pg8::GridOrder<pg8::MapPlain>, true, true>(lds, DM, DM, S, E);
        }
        SEAM();
    }
    if constexpr (f == 2) {
        if (IN()) modulate_rows(X, XC, MA, norm_g + (size_t)(ly * 3 + 1) * DM, modl + 3 * DM, modl + 4 * DM, H, gw, NGW, lane);
        SEAM();
        if (IN()) {
            pg8::EpiQKV E{QB, KB, VB, TABC, TABS, GQ, GK};
            for (int part = 0; part < 2; ++part) {
                pg8::MapPlain mp = part == 0 ? pg8::MapPlain{(const char*)H, (const char*)WQKV, (size_t)256 * DM * 2, (size_t)256 * DM * 2, DM / 64, 0, 0}
                                             : pg8::MapPlain{(const char*)(H + (size_t)ML * DM), (const char*)(WQKV + (size_t)2048 * DM), (size_t)256 * DM * 2, (size_t)256 * DM * 2, DM / 64, ML / 256, 8};
                pg8::GridOrder<pg8::MapPlain> S; S.init(part == 0 ? ML / 256 : MC / 256, part == 0 ? 12 : 4, G, bx, mp);
                pg8::gemm_phase<pg8::EpiQKV, pg8::GridOrder<pg8::MapPlain>, true, true>(lds, DM, DM, S, E);
            }
        }
        SEAM();
        if (IN()) {
            for (int L = vcu; L < NB * NH * (SEQ / 256); L += G) {
                const int pair = L >> 6, wi = L & 63, b = pair >> 2, kvh = pair & 3, h = kvh * 4 + (wi >> 4), qb = wi & 15;
                att::attn_dense_body(QB + ((size_t)(b * SEQ + qb * 256)) * DM + h * HD, KB + (size_t)(b * NKV + kvh) * SKV * HD, VB + (size_t)(b * NKV + kvh) * SKV * HD,
                                     OB + ((size_t)(b * SEQ + qb * 256)) * DM + h * HD, SKV, c.lds_gen);
            }
        }
        SEAM();
        if (IN()) {
            pg8::MapPlain mp{(const char*)OB, (const char*)WAO, (size_t)256 * DM * 2, (size_t)256 * DM * 2, DM / 64, 0, 0};
            pg8::GridOrder<pg8::MapPlain> S; S.init(ML / 256, DM / 256, G, bx, mp);
            pg8::EpiResid E{X, XC, X, XC, modl + 5 * DM, 1.0f};
            pg8::gemm_phase<pg8::EpiResid, pg8::GridOrder<pg8::MapPlain>, true, true>(lds, DM, DM, S, E);
        }
        SEAM();
    }
}
#undef IN
#undef SEAM

struct Args { const float* in[14]; float* out; unsigned char* ws; int ph_lo, ph_hi; };
constexpr int N_PHASES = 21;

__global__ void __launch_bounds__(512, 2) fwd(Args args) {
    extern __shared__ __attribute__((aligned(16))) unsigned char lds_raw[];
    LAS unsigned char* lds = (LAS unsigned char*)lds_raw;
    volatile LAS unsigned* MISC = (volatile LAS unsigned*)(lds + MISC_OFF);
    const int tid = threadIdx.x, lane = tid & 63, wave = __builtin_amdgcn_readfirstlane(tid >> 6);
    const int G = gridDim.x, bx = blockIdx.x;
    const int vcu = (G % 8 == 0) ? (bx % 8) * (G / 8) + bx / 8 : bx;
    unsigned char* ws = args.ws;
    unsigned* ctl = (unsigned*)(ws + WS_CTL);
    const float* x_in = args.in[0]; const float* c_in = args.in[1]; const float* ctx_in = args.in[2]; const float* cctx_in = args.in[3];
    const float* w_ada = args.in[4]; const float* b_ada = args.in[5]; const float* norm_g = args.in[6]; const float* w_ffn_in = args.in[7];
    const float* w_ffn_out = args.in[8]; const float* w_fo = args.in[9]; const float* w_qkv = args.in[10]; const float* qng = args.in[11];
    const float* kng = args.in[12]; const float* w_ao = args.in[13];
    float* X = args.out; float* XC = (float*)(ws + WS_XC);
    float* MOD = (float*)(ws + WS_MOD);
    float* TABC = (float*)(ws + WS_TAB); float* TABS = TABC + 2048; float* GQ = TABS + 2048; float* GK = GQ + 128;
    bf16* WCH = (bf16*)(ws + WS_WC); bf16* SEQC = WCH + 512 * 256; bf16* SEQM = (bf16*)(ws + WS_SEQ);
    bf16* WFO = (bf16*)(ws + WS_WFO); bf16* WQKV = (bf16*)(ws + WS_WQKV); bf16* WAO = (bf16*)(ws + WS_WAO);
    bf16* H = (bf16*)(ws + WS_H); bf16* HID = (bf16*)(ws + WS_HID); bf16* PQT = (bf16*)(ws + WS_PQT); bf16* PQTC = (bf16*)(ws + WS_PQTC);
    bf16* FB = (bf16*)(ws + WS_F); bf16* QB = (bf16*)(ws + WS_Q); bf16* KB = (bf16*)(ws + WS_K); bf16* VB = (bf16*)(ws + WS_V); bf16* OB = (bf16*)(ws + WS_O);

    for (int u = tid; u < (LDS_BYTES - RING_BYTES) / 4; u += 512) ((LAS unsigned*)(lds + RING_BYTES))[u] = 0u;
    __syncthreads();
    const int lo = args.ph_lo, hi = args.ph_hi;
    XcdBarrier bar; bar.bar = ctl + CW_BAR; bar.x = 0; bar.st = MISC + 8;
    if (hi - lo > 1) bar = xcd_barrier_post(ctl + CW_BAR, MISC + 8);
    int ph = 0;
#define IN() (lo <= ph && ph < hi)
#define SEAM() do { if (lo <= ph && ph + 1 < hi) xcd_barrier(bar); ++ph; } while (0)
    const int gw = vcu * 8 + wave, NGW = G * 8;

    if (IN()) {
        LAS float* lut = (LAS float*)lds;
        for (int j = tid; j < 4096; j += 512) lut[j] = cospif((float)j * (1.0f / 2048.0f));
        __syncthreads();
        {
            const int nchunk = 4096 * 1024;
            for (int ch = bx * 512 + tid; ch < nchunk; ch += G * 512) { const int k = ch >> 10, n8 = (ch & 1023) * 8; unsigned w[4];
#pragma unroll
                for (int e = 0; e < 4; ++e) { const int n0 = n8 + 2 * e, n1 = n0 + 1;
                    const int i0 = n0 < 4096 ? (k * n0) & 4095 : (k * (n0 - 4096) + 1024) & 4095, i1 = n1 < 4096 ? (k * n1) & 4095 : (k * (n1 - 4096) + 1024) & 4095;
                    w[e] = pk2(lut[i0], lut[i1]); }
                *(GAS v4u*)(SEQM + (size_t)ch * 8) = (v4u){w[0], w[1], w[2], w[3]}; }
            for (int e = bx * 512 + tid; e < 256 * 512; e += G * 512) { const int k = e >> 9, n = e & 511;
                SEQC[e] = (bf16)f2bf(lut[n < 256 ? (k * n * 16) & 4095 : (k * (n - 256) * 16 + 1024) & 4095]); }
            for (int e = bx * 512 + tid; e < 512 * 256; e += G * 512) { const int l = e >> 8, c = e & 255;
                WCH[e] = (bf16)f2bf(lut[l < 256 ? (l * c * 16) & 4095 : ((l - 256) * c * 16 + 3072) & 4095]); }
        }
        if (bx == 0) {
            for (int t = tid; t < 2048; t += 512) { const int pos = t >> 5, f = t & 31; const double inv = pow(10000.0, -(double)f / 32.0), ang = (double)pos * inv;
                TABC[t] = (float)cos(ang); TABS[t] = (float)sin(ang); }
            if (tid < 128) { const int i = tid >> 1, hf = tid & 1, d = (i < 32 ? i : i + 32) + 32 * hf; GQ[tid] = qng[d]; GK[tid] = kng[d]; }
        }
        __syncthreads();
        {
            LAS float* s_sh = (LAS float*)lds;
            LAS float* red = (LAS float*)(lds + 81920);
            for (int i = tid; i < 9 * DM; i += 512) { const int bp = i >> 11, k = i & 2047; const float cv = bp < 8 ? c_in[bp * DM + k] : cctx_in[k]; s_sh[i] = cv / (1.0f + expf(-cv)); }
            __syncthreads();
            const int cg = lane & 7, ksl = wave * 8 + (lane >> 3), k0 = ksl * 32;
            for (int it = bx; it < 2 * 576; it += G) {
                const int ly = it / 576, j0 = (it % 576) * 32;
                const float* wp = w_ada + (size_t)ly * DM * MODLD + (size_t)k0 * MODLD + j0 + 4 * cg;
                f32x4 a[9];
#pragma unroll
                for (int b = 0; b < 9; ++b) a[b] = (f32x4){0.f, 0.f, 0.f, 0.f};
                for (int kk = 0; kk < 32; kk += 4) {
                    const f32x4 w0 = *(const GAS f32x4*)(wp + (size_t)(kk + 0) * MODLD), w1 = *(const GAS f32x4*)(wp + (size_t)(kk + 1) * MODLD);
                    const f32x4 w2 = *(const GAS f32x4*)(wp + (size_t)(kk + 2) * MODLD), w3 = *(const GAS f32x4*)(wp + (size_t)(kk + 3) * MODLD);
#pragma unroll
                    for (int b = 0; b < 9; ++b) { const f32x4 s4 = *(const LAS f32x4*)(s_sh + b * DM + k0 + kk); a[b] += w0 * s4.x + w1 * s4.y + w2 * s4.z + w3 * s4.w; }
                }
#pragma unroll
                for (int b = 0; b < 9; ++b)
#pragma unroll
                    for (int e = 0; e < 4; ++e) { float v = a[b][e]; v += __shfl_xor(v, 8); v += __shfl_xor(v, 16); v += __shfl_xor(v, 32); a[b][e] = v; }
                if (lane < 8) {
#pragma unroll
                    for (int b = 0; b < 9; ++b) *(LAS f32x4*)(red + (wave * 8 + cg) * 36 + b * 4) = a[b]; }
                __syncthreads();
                if (tid < 288) { const int bp = tid >> 5, jj = tid & 31; float v = b_ada[(size_t)ly * MODLD + j0 + jj];
#pragma unroll
                    for (int w = 0; w < 8; ++w) v += red[(w * 8 + (jj >> 2)) * 36 + bp * 4 + (jj & 3)];
                    MOD[((size_t)ly * 9 + bp) * MODLD + j0 + jj] = v; }
                __syncthreads();
            }
        }
        {
            LAS float* scr = (LAS float*)(lds + wave * 16384);
            constexpr int I_IN = (DM / 64) * (2 * FF / 32), I_OUT = (FF / 64) * (DM / 32), I_SQ = (DM / 64) * (DM / 32), I_QKV = (DM / 64) * (NQKV / 32);
            constexpr int NITEMS = 4 * I_IN + 4 * I_OUT + 2 * I_SQ + I_QKV;
            for (int it = gw; it < NITEMS; it += NGW) {
                int r = it;
                if (r < 4 * I_IN) { const int f = r / I_IN; transpose_item<1>(w_ffn_in + (size_t)f * DM * 2 * FF, DM, 2 * FF, (bf16*)(ws + WS_WIN + (size_t)f * WIN_BYTES), scr, r % I_IN, lane); continue; } r -= 4 * I_IN;
                if (r < 4 * I_OUT) { const int f = r / I_OUT; transpose_item<0>(w_ffn_out + (size_t)f * FF * DM, FF, DM, (bf16*)(ws + WS_WOUT + (size_t)f * WOUT_BYTES), scr, r % I_OUT, lane); continue; } r -= 4 * I_OUT;
                if (r < I_SQ) { transpose_item<0>(w_fo, DM, DM, WFO, scr, r, lane); continue; } r -= I_SQ;
                if (r < I_SQ) { transpose_item<0>(w_ao, DM, DM, WAO, scr, r, lane); continue; } r -= I_SQ;
                transpose_item<2>(w_qkv, DM, NQKV, WQKV, scr, r, lane);
            }
        }
    }
    SEAM();

    {
        Ctx c; c.lds = lds; c.lds_gen = (char*)lds_raw; c.ws = ws; c.G = G; c.bx = bx; c.vcu = vcu; c.gw = gw; c.NGW = NGW; c.lane = lane; c.lo = lo; c.hi = hi;
        c.x_in = x_in; c.ctx_in = ctx_in; c.norm_g = norm_g; c.X = X; c.XC = XC; c.MOD = MOD; c.TABC = TABC; c.TABS = TABS; c.GQ = GQ; c.GK = GK;
        macaron_step<0>(c, bar, ph); macaron_step<1>(c, bar, ph); macaron_step<2>(c, bar, ph); macaron_step<3>(c, bar, ph);
    }
#undef IN
#undef SEAM
}

extern "C" void kernel_launch(void* const* d_in, const int* in_sizes, int n_in, void* d_out, int out_size, void* d_ws, size_t ws_size, hipStream_t stream) {
    static int grid = 0;
    if (grid == 0) {
        if (n_in != 14 || in_sizes[0] != ML * DM || out_size != ML * DM || ws_size < WS_END) { fprintf(stderr, "kernel_launch: shape/workspace mismatch (n_in %d, in0 %d, out %d, ws %zu, need %zu)\n", n_in, n_in > 0 ? in_sizes[0] : -1, out_size, ws_size, (size_t)WS_END); grid = -1; return; }
        int dev = 0, cus = 0, per_cu = 0;
        if (hipGetDevice(&dev) != hipSuccess || hipDeviceGetAttribute(&cus, hipDeviceAttributeMultiprocessorCount, dev) != hipSuccess) { grid = -1; return; }
        if (hipFuncSetAttribute((const void*)fwd, hipFuncAttributeMaxDynamicSharedMemorySize, LDS_BYTES) != hipSuccess) { fprintf(stderr, "kernel_launch: hipFuncSetAttribute failed\n"); grid = -1; return; }
        if (hipOccupancyMaxActiveBlocksPerMultiprocessor(&per_cu, (const void*)fwd, 512, LDS_BYTES) != hipSuccess || per_cu < 1) fprintf(stderr, "kernel_launch: occupancy query says %d\n", per_cu);
        (void)hipGetLastError();
        grid = cus;
    }
    if (grid < 0) return;
    (void)hipMemsetAsync((char*)d_ws + WS_CTL, 0, CTL_ZERO_BYTES, stream);
    Args a{};
    for (int i = 0; i < 14; ++i) a.in[i] = (const float*)d_in[i];
    a.out = (float*)d_out; a.ws = (unsigned char*)d_ws;
#if MK_ONE_LAUNCH
    a.ph_lo = 0; a.ph_hi = N_PHASES;
    hipLaunchKernelGGL(fwd, dim3(grid), dim3(512), LDS_BYTES, stream, a);
#else
    for (int p = 0; p < N_PHASES; ++p) { a.ph_lo = p; a.ph_hi = p + 1; hipLaunchKernelGGL(fwd, dim3(grid), dim3(512), LDS_BYTES, stream, a); }
#endif
    const hipError_t le = hipPeekAtLastError();
    if (le != hipSuccess) fprintf(stderr, "kernel_launch: launch failed: %s\n", hipGetErrorName(le));
}
```

```cpp
#include <hip/hip_runtime.h>
#include <cstdio>
#include <cstdint>

#ifndef PROBE_AMP
#define PROBE_AMP 8
#endif
#ifndef MK_ONE_LAUNCH
#define MK_ONE_LAUNCH 1
#endif

#define GAS __attribute__((address_space(1)))
#define LAS __attribute__((address_space(3)))
#define PG8_LAS __attribute__((address_space(3)))

constexpr int NB = 8, SEQ = 4096, DM = 2048, CTXL = 256, FF = 5632, NMOD = 9;
constexpr int ML = NB * SEQ, MC = NB * CTXL, MA = ML + MC;
constexpr int NQKV = 3072, HD = 128, NH = 16, NKV = 4, SKV = SEQ + CTXL;
constexpr int MODLD = NMOD * DM;
constexpr float EPS = 1e-6f;

constexpr size_t MiB = 1u << 20;
constexpr size_t WS_CTL = 0, CTL_ZERO_BYTES = 1 * MiB;
constexpr size_t WS_MOD = 1 * MiB;
constexpr size_t WS_TAB = 3 * MiB;
constexpr size_t WS_WC = 4 * MiB;
constexpr size_t WS_SEQ = 5 * MiB;
constexpr size_t WS_WIN = 69 * MiB;
constexpr size_t WS_WOUT = 245 * MiB;
constexpr size_t WS_WFO = 333 * MiB, WS_WQKV = 341 * MiB, WS_WAO = 353 * MiB;
constexpr size_t WS_XC = 361 * MiB;
constexpr size_t WS_H = 377 * MiB;
constexpr size_t WS_HID = 513 * MiB;
constexpr size_t WS_PQT = WS_HID, WS_PQTC = WS_HID + 256 * MiB;
constexpr size_t WS_F = 887 * MiB;
constexpr size_t WS_Q = 1023 * MiB;
constexpr size_t WS_K = 1151 * MiB, WS_V = 1185 * MiB;
constexpr size_t WS_O = 1219 * MiB;
constexpr size_t WS_BIAS = 1347 * MiB;
constexpr size_t WS_END = 1349 * MiB;
constexpr size_t WIN_BYTES = (size_t)2 * FF * DM * 2, WOUT_BYTES = (size_t)DM * FF * 2;
constexpr int CW_BAR = 4096, CW_TICK = 16384, CW_SS = 65536;
constexpr int BIAS_IN_LD = 2 * FF, BIAS_QKV_OFF = 4 * 9 * BIAS_IN_LD;
constexpr size_t SHB_OFF = 393216;
constexpr int CW_HA = 240000;
constexpr size_t TAB_HM = 65536, TAB_PH = 327680, TAB_PHW = 655360;

constexpr int RING_BYTES = 131072, XCH_OFF = RING_BYTES  , MISC_OFF = RING_BYTES + 8192 + 320, LDS_BYTES = 147456;

typedef unsigned short bf16;
typedef unsigned v4u __attribute__((ext_vector_type(4)));
typedef unsigned v2u __attribute__((ext_vector_type(2)));
typedef float f32x4 __attribute__((ext_vector_type(4)));
#define LDS_WAIT() asm volatile("s_waitcnt lgkmcnt(0)" ::: "memory")
#define VM_WAIT() asm volatile("s_waitcnt vmcnt(0)" ::: "memory")
__device__ __forceinline__ unsigned f2bf(float f) { unsigned u = __builtin_bit_cast(unsigned, f); return (u + 0x7fffu + ((u >> 16) & 1u)) >> 16; }
__device__ __forceinline__ unsigned pk2(float lo, float hi) { return f2bf(lo) | (f2bf(hi) << 16); }
__device__ __forceinline__ unsigned cvt_pk_bf16(float lo, float hi) { unsigned r; asm volatile("v_cvt_pk_bf16_f32 %0, %1, %2" : "=v"(r) : "v"(lo), "v"(hi)); return r; }
__device__ __forceinline__ int lane_id() { unsigned m = ~0u; asm volatile("" : "+v"(m)); return (int)__builtin_amdgcn_mbcnt_hi(m, __builtin_amdgcn_mbcnt_lo(m, 0u)); }
__device__ __forceinline__ int lane_id_fresh() { unsigned m = ~0u; asm volatile("" : "+v"(m)); return (int)__builtin_amdgcn_mbcnt_hi(m, __builtin_amdgcn_mbcnt_lo(m, 0u)); }
__device__ __forceinline__ float wave_sum(float v) {
#pragma unroll
    for (int o = 1; o < 64; o <<= 1) v += __shfl_xor(v, o);
    return v;
}
__device__ __forceinline__ float silu_f(float g) { return g * __builtin_amdgcn_rcpf(1.0f + __builtin_amdgcn_exp2f(-1.4426950408889634f * g)); }

namespace pg8 {
typedef unsigned short bf16_t;
typedef short bf16x8 __attribute__((ext_vector_type(8)));
typedef float f32x4 __attribute__((ext_vector_type(4)));
typedef unsigned u32x4 __attribute__((ext_vector_type(4)));
constexpr int BM = 256, BK = 64, HALF = 128, HTB = HALF * BK * 2, STAGE_BYTES = 8 * HTB, NXCD = 8, WGM = 8;
__host__ __device__ __forceinline__ int lds_byte(int r, int c) { const int st = (r >> 4) * 2 + (c >> 5), rr = r & 15, cc = c & 31, ob = rr * 64 + cc * 2; return st * 1024 + (ob ^ (((ob >> 9) & 1) << 5)); }
__host__ __device__ __forceinline__ void stage_rc(int b, int& R, int& C) { const int st = b / 1024, sb = b % 1024, swz = sb ^ (((sb >> 9) & 1) << 5); R = (st >> 1) * 16 + swz / 64; C = (st & 1) * 32 + (swz % 64) / 2; }
__host__ __device__ __forceinline__ int perm32(int rho) { const int n = rho >> 4, i = rho & 15; return 8 * (i >> 2) + 4 * n + (i & 3); }

struct Unit { const char* A; const char* B; int nt, pm, pn, split; };

template <class Map> struct GridOrder {
    int nM, nN, nwg, G, c, wgm; Map map;
    __device__ __forceinline__ void init(int nM_, int nN_, int G_, int c_, const Map& m) { nM = nM_; nN = nN_; nwg = nM * nN; G = G_; asm volatile("" : "+s"(c_)); c = c_; map = m; wgm = WGM; }
    __device__ __forceinline__ void at(int L, Unit& u) const {
        int wgid = L; { const int q = nwg / NXCD, r = nwg % NXCD, xcd = wgid % NXCD, off = wgid / NXCD; wgid = (xcd < r ? xcd * (q + 1) : r * (q + 1) + (xcd - r) * q) + off; }
        const int nig = wgm * nN, gid = wgid / nig, fm = gid * wgm, gsz = (nM - fm) < wgm ? (nM - fm) : wgm;
        u.pm = fm + ((wgid % nig) % gsz); u.pn = (wgid % nig) / gsz; u.split = 0; map.fill(u);
    }
    __device__ __forceinline__ bool next(int i, Unit& u) const { const long L = (long)i * G + c; if (L >= nwg) return false; at((int)L, u); return true; }
};
struct MapPlain { const char* A; const char* B; unsigned astep, bstep; int nt, pm_off, pn_off;
    __device__ __forceinline__ void fill(Unit& u) const { u.A = A + (size_t)u.pm * astep; u.B = B + (size_t)u.pn * bstep; u.nt = nt; u.pm += pm_off; u.pn += pn_off; } };
struct ResidOrder { GridOrder<MapPlain> lat; int n_ctx; const char* Ac; unsigned ksplit; int nt_split;
    __device__ __forceinline__ bool next(int i, Unit& u) const {
        const long L = (long)i * lat.G + lat.c; if (L < lat.nwg) { lat.at((int)L, u); return true; }
        const int j = (int)(L - lat.nwg); if (j >= n_ctx) return false;
        const int ks = j >> 6, t = j & 63, pmc = t & 7, pn = t >> 3;
        u.A = Ac + (size_t)pmc * lat.map.astep + (size_t)ks * ksplit; u.B = lat.map.B + (size_t)pn * lat.map.bstep + (size_t)ks * ksplit; u.nt = nt_split; u.pm = ML / BM + pmc; u.pn = pn; u.split = ks + 1; return true; }
};
struct F1Order { int G, c; const char* Wc; const char* H;
    __device__ __forceinline__ bool next(int i, Unit& u) const {
        const long L = (long)i * G + c; int g, part, row0;
        if (L < 8 * 4 * 32) { const int pm = (int)L >> 5, pn = (int)L & 31; g = pm >> 2; part = pm & 3; row0 = (((pn >> 2) * 4 + part) * 1024) + (pn & 3) * 256; u.pm = pm; u.pn = pn; }
        else { const int j = (int)(L - 8 * 4 * 32); if (j >= 8 * 2 * 4) return false; g = j >> 3; const int cp = (j >> 2) & 1, tt = j & 3; part = 2 * cp; row0 = ML + cp * 1024 + tt * 256; u.pm = g * 4 + part; u.pn = 32 + tt; }
        u.A = Wc + (size_t)(part >= 2 ? 256 : 0) * 256 * 2; u.B = H + ((size_t)row0 * DM + g * 256) * 2; int n4 = 4; asm volatile("" : "+s"(n4)); u.nt = n4; u.split = 0; return true; }
};
struct MapF2 { const char* S; const char* P; size_t a_tile, p_batch, p_tile; int ktshift, nt, pm_off;
    __device__ __forceinline__ void fill(Unit& u) const { const int b = u.pm >> ktshift, kt = u.pm & ((1 << ktshift) - 1); u.A = S + (size_t)kt * a_tile; u.B = P + (size_t)b * p_batch + (size_t)u.pn * p_tile; u.nt = nt; u.pm += pm_off; } };

struct MapUV { const char* A2; const char* P;
    __device__ __forceinline__ void fill(Unit& u) const { const int b = u.pm >> 4, kind = (u.pm >> 2) & 3, kt = u.pm & 3;
        u.A = A2 + ((size_t)kind * 1024 + (size_t)kt * 256) * 1024 * 2; u.B = P + ((size_t)b * DM + (size_t)u.pn * 256) * 4096 * 2 + (size_t)kind * 1024 * 2; u.nt = 1024 / 64; } };

struct EpiSwiGLU {
    static constexpr bool PERM = true;
    bf16_t* HID; const float* ss; const float* bias;
    __device__ __forceinline__ void operator()(f32x4 (&acc)[2][2][4][2], const Unit& u, int wr, int wc, int fr, int fq, PG8_LAS unsigned char*) const {
        asm volatile("" : "+v"(fr), "+v"(fq));
        const int row0 = u.pm * BM + wr * 64 + fr, hc = u.pn * 128 + wc * 32 + 8 * fq;
        const int bp = u.pm < (ML / BM) ? (u.pm >> 4) : 8;
        const float* bq = bias + (size_t)bp * BIAS_IN_LD + u.pn * BM + wc * 32 + 8 * fq;
        const f32x4 bg0 = *(const f32x4*)bq, bg1 = *(const f32x4*)(bq + 4), bu0 = *(const f32x4*)(bq + HALF), bu1 = *(const f32x4*)(bq + HALF + 4);
        float rs[2][4];
#pragma unroll
        for (int ai = 0; ai < 2; ++ai)
#pragma unroll
            for (int m = 0; m < 4; ++m) rs[ai][m] = ss[row0 + ai * HALF + m * 16];
#pragma unroll
        for (int ai = 0; ai < 2; ++ai)
#pragma unroll
            for (int m = 0; m < 4; ++m) {
                const float r = __builtin_amdgcn_rsqf(rs[ai][m] * (1.0f / DM) + EPS);
                const f32x4 g0 = acc[ai][0][m][0] * r + bg0, g1 = acc[ai][0][m][1] * r + bg1, u0 = acc[ai][1][m][0] * r + bu0, u1 = acc[ai][1][m][1] * r + bu1;
                u32x4 w;
                w.x = cvt_pk_bf16(silu_f(g0[0]) * u0[0], silu_f(g0[1]) * u0[1]); w.y = cvt_pk_bf16(silu_f(g0[2]) * u0[2], silu_f(g0[3]) * u0[3]);
                w.z = cvt_pk_bf16(silu_f(g1[0]) * u1[0], silu_f(g1[1]) * u1[1]); w.w = cvt_pk_bf16(silu_f(g1[2]) * u1[2], silu_f(g1[3]) * u1[3]);
                *(u32x4*)(HID + (size_t)(row0 + ai * HALF + m * 16) * FF + hc) = w;
            }
    }
};
template <bool HALFC, bool NEXT, bool MIRROR = false> struct EpiResid {
    static constexpr bool PERM = true;
    const float* xin_l; const float* xin_c; float* xout_l; unsigned char* ws; int gate_off, tick_off;
    const float* ng; int nscale_off, ss_off;
    __device__ __forceinline__ void colvecs(f32x4 (&gv)[2][2], f32x4 (&vv)[2][2], const float* gb, unsigned c4, int bp) const {
#pragma unroll
        for (int bj = 0; bj < 2; ++bj)
#pragma unroll
            for (int n = 0; n < 2; ++n) { gv[bj][n] = *(const f32x4*)((const char*)gb + (size_t)(c4 + (unsigned)((bj * HALF + n * 4) * 4))); if (HALFC) gv[bj][n] *= 0.5f; }
        if constexpr (NEXT) { const float* sb = (const float*)(ws + WS_MOD) + nscale_off + (size_t)bp * MODLD;
#pragma unroll
            for (int bj = 0; bj < 2; ++bj)
#pragma unroll
                for (int n = 0; n < 2; ++n) { const unsigned o = c4 + (unsigned)((bj * HALF + n * 4) * 4); vv[bj][n] = *(const f32x4*)((const char*)ng + (size_t)o) * (*(const f32x4*)((const char*)sb + (size_t)o) + 1.0f); } }
    }
    __device__ __forceinline__ void loadg(f32x4 (&xv)[2][2], const float* xin, unsigned lo4, int roff) const {
        const unsigned o = lo4 + (unsigned)(roff * DM * 4);
#pragma unroll
        for (int bj = 0; bj < 2; ++bj)
#pragma unroll
            for (int n = 0; n < 2; ++n) xv[bj][n] = *(const f32x4*)((const char*)xin + (size_t)(o + (unsigned)((bj * HALF + n * 4) * 4)));
    }
    __device__ __forceinline__ void fing(const f32x4 (&q)[2][2], f32x4 (&xv)[2][2], float* xout, const f32x4 (&gv)[2][2], const f32x4 (&vv)[2][2], unsigned lo4, int roff, bf16_t* xs_t, float* ss_t, int rl0, int fq) const {
        const unsigned o = lo4 + (unsigned)(roff * DM * 4);
#pragma unroll
        for (int bj = 0; bj < 2; ++bj)
#pragma unroll
            for (int n = 0; n < 2; ++n) { xv[bj][n] += gv[bj][n] * q[bj][n]; *(f32x4*)((char*)xout + (size_t)(o + (unsigned)((bj * HALF + n * 4) * 4))) = xv[bj][n]; }
        if constexpr (NEXT) {
            float sq = 0.f;
#pragma unroll
            for (int bj = 0; bj < 2; ++bj) { const f32x4 x0 = xv[bj][0], x1 = xv[bj][1];
                sq += ((x0[0] * x0[0] + x0[1] * x0[1]) + (x0[2] * x0[2] + x0[3] * x0[3])) + ((x1[0] * x1[0] + x1[1] * x1[1]) + (x1[2] * x1[2] + x1[3] * x1[3]));
                const f32x4 y0 = x0 * vv[bj][0], y1 = x1 * vv[bj][1];
                u32x4 w; w.x = cvt_pk_bf16(y0[0], y0[1]); w.y = cvt_pk_bf16(y0[2], y0[3]); w.z = cvt_pk_bf16(y1[0], y1[1]); w.w = cvt_pk_bf16(y1[2], y1[3]);
                *(u32x4*)((char*)xs_t + (size_t)((o >> 1) + (unsigned)(bj * HALF * 2))) = w; }
            sq += __shfl_xor(sq, 16); sq += __shfl_xor(sq, 32);
            if (fq == 0) unsafeAtomicAdd((float*)((char*)ss_t + (size_t)((unsigned)(rl0 + roff) * 4u)), sq);
        }
        asm volatile("" ::: "memory");
    }
    template <int AI, int M> __device__ __forceinline__ void takeg(f32x4 (&q)[2][2], const f32x4 (&acc)[2][2][4][2]) const {
#pragma unroll
        for (int bj = 0; bj < 2; ++bj)
#pragma unroll
            for (int n = 0; n < 2; ++n) q[bj][n] = acc[AI][bj][M][n];
    }
    template <int AI, int MH> __device__ __forceinline__ void put_quarter(const f32x4 (&acc)[2][2][4][2], __amdgpu_buffer_rsrc_t rsrc, unsigned off) const {
#pragma unroll
        for (int mm = 0; mm < 2; ++mm)
#pragma unroll
            for (int bj = 0; bj < 2; ++bj)
#pragma unroll
                for (int n = 0; n < 2; ++n) __builtin_amdgcn_raw_buffer_store_b128(__builtin_bit_cast(u32x4, acc[AI][bj][2 * MH + mm][n]), rsrc, off + (unsigned)(((mm * 2 + bj) * 2 + n) * 1024), 0, 16);
    }
    template <int M, int SIGN> __device__ __forceinline__ void mrows(const f32x4 (&acc)[2][2][4][2], const f32x4 (&pc)[2][2], const f32x4 (&pd)[2][2], const float* special, int row, unsigned c4, float* xb, bf16_t* xsb, float* ssb,
                                                                      const f32x4 (&gv)[2][2], const f32x4 (&vv)[2][2], int fq) const {
        const unsigned o = (unsigned)row * (unsigned)(DM * 4) + c4; f32x4 xv[2][2];
#pragma unroll
        for (int bj = 0; bj < 2; ++bj)
#pragma unroll
            for (int n = 0; n < 2; ++n) xv[bj][n] = *(const f32x4*)((const char*)xb + (size_t)(o + (unsigned)((bj * HALF + n * 4) * 4)));
#pragma unroll
        for (int bj = 0; bj < 2; ++bj)
#pragma unroll
            for (int n = 0; n < 2; ++n) { f32x4 v = SIGN > 0 ? (acc[0][bj][M][n] + acc[1][bj][M][n]) + (pc[bj][n] + pd[bj][n]) : (acc[0][bj][M][n] - acc[1][bj][M][n]) + (pc[bj][n] - pd[bj][n]);
                if (SIGN > 0) { if (special) v = *(const f32x4*)((const char*)special + (size_t)(c4 + (unsigned)((bj * HALF + n * 4) * 4))); }
                xv[bj][n] += gv[bj][n] * v; *(f32x4*)((char*)xb + (size_t)(o + (unsigned)((bj * HALF + n * 4) * 4))) = xv[bj][n]; }
        float sq = 0.f;
#pragma unroll
        for (int bj = 0; bj < 2; ++bj) { const f32x4 x0 = xv[bj][0], x1 = xv[bj][1];
            sq += ((x0[0] * x0[0] + x0[1] * x0[1]) + (x0[2] * x0[2] + x0[3] * x0[3])) + ((x1[0] * x1[0] + x1[1] * x1[1]) + (x1[2] * x1[2] + x1[3] * x1[3]));
            const f32x4 y0 = x0 * vv[bj][0], y1 = x1 * vv[bj][1];
            u32x4 w; w.x = cvt_pk_bf16(y0[0], y0[1]); w.y = cvt_pk_bf16(y0[2], y0[3]); w.z = cvt_pk_bf16(y1[0], y1[1]); w.w = cvt_pk_bf16(y1[2], y1[3]);
            *(u32x4*)((char*)xsb + (size_t)((o >> 1) + (unsigned)(bj * HALF * 2))) = w; }
        sq += __shfl_xor(sq, 16); sq += __shfl_xor(sq, 32);
        if (fq == 0) unsafeAtomicAdd(ssb + row, sq);
        asm volatile("" ::: "memory");
    }
    __device__ __forceinline__ void mirror(const f32x4 (&acc)[2][2][4][2], const Unit& u, int wr, int wc, int fr, int fq, const float* gb) const {
        const int b = u.pm >> 4, par = (u.pm >> 3) & 1, jb = u.pm & 7, col0 = u.pn * BM + wc * 32 + 8 * fq; const unsigned c4 = (unsigned)col0 * 4u;
        float* xb = xout_l + (size_t)b * SEQ * DM; bf16_t* xsb = (bf16_t*)(ws + WS_H) + (size_t)b * SEQ * DM; float* ssb = (float*)(ws + WS_CTL) + ss_off + b * SEQ;
        const float* phw = (const float*)(ws + WS_TAB + TAB_PHW) + (size_t)b * DM; const float sk = par ? -1.0f : 1.0f, sj = (fr & 1) ? -1.0f : 1.0f;
        f32x4 gv[2][2], vv[2][2], pc[2][2], pd[2][2];
        colvecs(gv, vv, gb, c4, b);
#pragma unroll
        for (int bj = 0; bj < 2; ++bj)
#pragma unroll
            for (int n = 0; n < 2; ++n) { const size_t o = (size_t)(c4 + (unsigned)((bj * HALF + n * 4) * 4));
                const f32x4 c0 = *(const f32x4*)((const char*)phw + o), cx = *(const f32x4*)((const char*)(phw + (size_t)(par ? 24 : 16) * DM) + o);
                pc[bj][n] = c0 * sk + (par ? (f32x4){0.f, 0.f, 0.f, 0.f} : cx * sj); pd[bj][n] = par ? cx * sj : (f32x4){0.f, 0.f, 0.f, 0.f}; }
        const int k0 = 2 * (jb * 128 + wr * 64 + fr) + par;
#define MR(M) { const int k = k0 + 32 * M; mrows<M, -1>(acc, pc, pd, nullptr, k, c4, xb, xsb, ssb, gv, vv, fq); \
                mrows<M, 1>(acc, pc, pd, k == 0 ? phw + (size_t)8 * DM : nullptr, k == 0 ? SEQ / 2 : SEQ - k, c4, xb, xsb, ssb, gv, vv, fq); }
        MR(0) MR(1) MR(2) MR(3)
#undef MR
    }
    __device__ __forceinline__ void operator()(f32x4 (&acc)[2][2][4][2], const Unit& u, int wr, int wc, int fr, int fq, PG8_LAS unsigned char*) const {
        const bool lat = u.pm < (ML / BM); const int bp = lat ? (u.pm >> 4) : 8;
        const float* xin = lat ? xin_l + (size_t)u.pm * BM * DM : xin_c + (size_t)(u.pm - ML / BM) * BM * DM;
        float* xout = lat ? xout_l + (size_t)u.pm * BM * DM : (float*)(ws + WS_XC) + (size_t)(u.pm - ML / BM) * BM * DM;
        const float* gate = (const float*)(ws + WS_MOD) + gate_off; float* slab = (float*)(ws + WS_O); unsigned* tick = (unsigned*)(ws + WS_CTL) + tick_off;
        const float* gb = gate + (size_t)bp * MODLD;
        bf16_t* xs_t = (bf16_t*)(ws + WS_H) + (size_t)u.pm * BM * DM; float* ss_t = (float*)(ws + WS_CTL) + ss_off + u.pm * BM;
        if constexpr (MIRROR) { if (lat) { mirror(acc, u, wr, wc, fr, fq, gb); return; } }
        if (u.split == 0) {
            const int rl0 = wr * 64 + fr, col0 = u.pn * BM + wc * 32 + 8 * fq; const unsigned c4 = (unsigned)col0 * 4u, lo4 = (unsigned)(rl0 * DM + col0) * 4u;
            f32x4 gv[2][2], vv[2][2], q[2][2], x0[2][2];
            colvecs(gv, vv, gb, c4, bp);
#define RG(AI, M) loadg(x0, xin, lo4, AI * HALF + M * 16); takeg<AI, M>(q, acc); fing(q, x0, xout, gv, vv, lo4, AI * HALF + M * 16, xs_t, ss_t, rl0, fq);
            RG(0, 0) RG(0, 1) RG(0, 2) RG(0, 3) RG(1, 0) RG(1, 1) RG(1, 2) RG(1, 3)
#undef RG
            return; }
        const int ks = u.split - 1, t = (u.pm - ML / BM) + 8 * u.pn, wid = wr * 4 + wc;
        {
            const int lane = fq * 16 + fr;
            const unsigned long long sb = (unsigned long long)(slab + (size_t)(t * 4 + ks) * 65536);
            float* sbase = (float*)(((unsigned long long)(unsigned)__builtin_amdgcn_readfirstlane((int)(sb >> 32)) << 32) | (unsigned)__builtin_amdgcn_readfirstlane((int)(unsigned)sb));
            const __amdgpu_buffer_rsrc_t rsrc = __builtin_amdgcn_make_buffer_rsrc(sbase, 0, 262144, 0x00020000);
            const unsigned lo = (unsigned)(wid * 8192 + lane * 16);
            put_quarter<0, 0>(acc, rsrc, lo); put_quarter<0, 1>(acc, rsrc, 65536u + lo); put_quarter<1, 0>(acc, rsrc, 131072u + lo); put_quarter<1, 1>(acc, rsrc, 196608u + lo);
        }
        asm volatile("s_waitcnt vmcnt(0)" ::: "memory"); __builtin_amdgcn_s_barrier(); asm volatile("" ::: "memory");
        if (wid == 0 && lane_id() == 0) (void)__hip_atomic_fetch_add(tick + 64 * t, 1u, __ATOMIC_RELAXED, __HIP_MEMORY_SCOPE_AGENT);
    }
    __device__ __forceinline__ void finish_ctx(const Unit& u, int wave) const {
        const int ks = u.split - 1, t = (u.pm - ML / BM) + 8 * u.pn, wr = wave >> 2, wc = wave & 3;
        float* slab = (float*)(ws + WS_O); unsigned* tk = (unsigned*)(ws + WS_CTL) + tick_off + 64 * t;
        if (wave == 0 && lane_id() == 0) {
            unsigned sp = 0; while (__hip_atomic_load(tk, __ATOMIC_RELAXED, __HIP_MEMORY_SCOPE_AGENT) < 4u) { __builtin_amdgcn_s_sleep(2); if (++sp > (1u << 21)) break; }
            __builtin_amdgcn_fence(__ATOMIC_ACQUIRE, "agent");
        }
        asm volatile("s_waitcnt vmcnt(0)" ::: "memory"); __builtin_amdgcn_s_barrier(); asm volatile("" ::: "memory");
        const int l2 = lane_id(), fr = l2 & 15, fq = l2 >> 4, rl0 = wr * 64 + fr, col0 = u.pn * BM + wc * 32 + 8 * fq;
        const unsigned c4 = (unsigned)col0 * 4u, lo4 = (unsigned)(rl0 * DM + col0) * 4u, mo4 = (unsigned)(ks * 16384 + wave * 2048 + l2 * 4) * 4u;
        const float* xin = xin_c + (size_t)(u.pm - ML / BM) * BM * DM; float* xout = (float*)(ws + WS_XC) + (size_t)(u.pm - ML / BM) * BM * DM;
        const float* gb = (const float*)(ws + WS_MOD) + gate_off + (size_t)8 * MODLD;
        bf16_t* xs_t = (bf16_t*)(ws + WS_H) + (size_t)u.pm * BM * DM; float* ss_t = (float*)(ws + WS_CTL) + ss_off + u.pm * BM;
        f32x4 gv[2][2], vv[2][2];
        colvecs(gv, vv, gb, c4, 8);
#pragma unroll
        for (int mm = 0; mm < 2; ++mm) { const int roff = (ks >> 1) * HALF + (2 * (ks & 1) + mm) * 16;
            f32x4 xv[2][2], own[2][2], tv[4][2][2]; loadg(xv, xin, lo4, roff);
#pragma unroll
            for (int o = 0; o < 4; ++o) { const char* src = (const char*)(slab + ((size_t)t * 4 + o) * 65536);
#pragma unroll
                for (int bj = 0; bj < 2; ++bj)
#pragma unroll
                    for (int n = 0; n < 2; ++n) tv[o][bj][n] = *(const f32x4*)(src + (size_t)(mo4 + (unsigned)(((mm * 2 + bj) * 2 + n) * 1024))); }
#pragma unroll
            for (int bj = 0; bj < 2; ++bj)
#pragma unroll
                for (int n = 0; n < 2; ++n) own[bj][n] = (tv[0][bj][n] + tv[1][bj][n]) + (tv[2][bj][n] + tv[3][bj][n]);
            fing(own, xv, xout, gv, vv, lo4, roff, xs_t, ss_t, rl0, fq); }
    }
};
template <class EpiR> __device__ __forceinline__ void finish_split_units(const ResidOrder& S, const EpiR& E, int wave) {
    for (int i = 0;; ++i) { Unit u; if (!S.next(i, u)) break; if (u.split != 0) E.finish_ctx(u, wave); }
}
struct EpiF1 {
    static constexpr bool PERM = true;
    bf16_t* PQT; bf16_t* PQTC;
    __device__ __forceinline__ void operator()(f32x4 (&acc)[2][2][4][2], const Unit& u, int wr, int wc, int fr, int fq, PG8_LAS unsigned char*) const {
        const int g = u.pm >> 2, part = u.pm & 3; const bool lat = u.pn < 32;
        const int l0 = wr * 64 + fr, tc = wc * 32 + 8 * fq;
#pragma unroll
        for (int ai = 0; ai < 2; ++ai)
#pragma unroll
            for (int m = 0; m < 4; ++m) { const int l = g * 256 + l0 + ai * HALF + m * 16;
#pragma unroll
                for (int bj = 0; bj < 2; ++bj) { const f32x4 v0 = acc[ai][bj][m][0], v1 = acc[ai][bj][m][1];
                    u32x4 w; w.x = cvt_pk_bf16(v0[0], v0[1]); w.y = cvt_pk_bf16(v0[2], v0[3]); w.z = cvt_pk_bf16(v1[0], v1[1]); w.w = cvt_pk_bf16(v1[2], v1[3]);
                    const int t = tc + bj * HALF;
                    bf16_t* dst = lat ? PQT + ((size_t)((u.pn >> 2) * DM + l)) * 4096 + part * 1024 + (u.pn & 3) * 256 + t
                                      : PQTC + ((size_t)((2 * (u.pn - 32) + (t >> 7)) * DM + l)) * 256 + (part >> 1) * 128 + (t & 127);
                    *(u32x4*)dst = w; } }
    }
};
struct EpiBf16S {
    static constexpr bool PERM = true;
    bf16_t* O; int ldc; float scale;
    __device__ __forceinline__ void operator()(f32x4 (&acc)[2][2][4][2], const Unit& u, int wr, int wc, int fr, int fq, PG8_LAS unsigned char*) const {
        const int row0 = u.pm * BM + wr * 64 + fr, col0 = u.pn * BM + wc * 32 + 8 * fq;
#pragma unroll
        for (int ai = 0; ai < 2; ++ai)
#pragma unroll
            for (int m = 0; m < 4; ++m) { bf16_t* rowp = O + (size_t)(row0 + ai * HALF + m * 16) * ldc + col0;
#pragma unroll
                for (int bj = 0; bj < 2; ++bj) { const f32x4 v0 = acc[ai][bj][m][0] * scale, v1 = acc[ai][bj][m][1] * scale;
                    u32x4 w; w.x = cvt_pk_bf16(v0[0], v0[1]); w.y = cvt_pk_bf16(v0[2], v0[3]); w.z = cvt_pk_bf16(v1[0], v1[1]); w.w = cvt_pk_bf16(v1[2], v1[3]);
                    *(u32x4*)(rowp + bj * HALF) = w; } }
    }
};
struct EpiF2 {
    static constexpr bool PERM = true;
    bf16_t* O; const float* PH; float scale;
    __device__ __forceinline__ void operator()(f32x4 (&acc)[2][2][4][2], const Unit& u, int wr, int wc, int fr, int fq, PG8_LAS unsigned char*) const {
        const int bb = u.pm < (ML / BM) ? (u.pm >> 4) : (8 + u.pm - ML / BM);
        const int row0 = u.pm * BM + wr * 64 + fr, col0 = u.pn * BM + wc * 32 + 8 * fq;
        const float sg = (fr & 1) ? -1.0f : 1.0f;
        f32x4 ph[2][2];
#pragma unroll
        for (int bj = 0; bj < 2; ++bj)
#pragma unroll
            for (int n = 0; n < 2; ++n) ph[bj][n] = *(const f32x4*)(PH + (size_t)bb * DM + col0 + bj * HALF + 4 * n) * sg;
#pragma unroll
        for (int ai = 0; ai < 2; ++ai)
#pragma unroll
            for (int m = 0; m < 4; ++m) { bf16_t* rowp = O + (size_t)(row0 + ai * HALF + m * 16) * DM + col0;
#pragma unroll
                for (int bj = 0; bj < 2; ++bj) { const f32x4 v0 = (acc[ai][bj][m][0] + ph[bj][0]) * scale, v1 = (acc[ai][bj][m][1] + ph[bj][1]) * scale;
                    u32x4 w; w.x = cvt_pk_bf16(v0[0], v0[1]); w.y = cvt_pk_bf16(v0[2], v0[3]); w.z = cvt_pk_bf16(v1[0], v1[1]); w.w = cvt_pk_bf16(v1[2], v1[3]);
                    *(u32x4*)(rowp + bj * HALF) = w; } }
    }
};
struct EpiUV {
    static constexpr bool PERM = true;
    bf16_t* UV;
    __device__ __forceinline__ void operator()(f32x4 (&acc)[2][2][4][2], const Unit& u, int wr, int wc, int fr, int fq, PG8_LAS unsigned char*) const {
        const int b = u.pm >> 4, kind = (u.pm >> 2) & 3, kt = u.pm & 3, uv = kind >> 1, par = kind & 1, col0 = u.pn * BM + wc * 32 + 8 * fq;
#pragma unroll
        for (int ai = 0; ai < 2; ++ai)
#pragma unroll
            for (int m = 0; m < 4; ++m) { bf16_t* rowp = UV + ((size_t)(((b * 16 + par * 8 + kt * 2 + ai) * 2 + uv) * 128 + wr * 64 + m * 16 + fr)) * DM + col0;
#pragma unroll
                for (int bj = 0; bj < 2; ++bj) { const f32x4 v0 = acc[ai][bj][m][0] * (1.0f / 1024.0f), v1 = acc[ai][bj][m][1] * (1.0f / 1024.0f);
                    u32x4 w; w.x = cvt_pk_bf16(v0[0], v0[1]); w.y = cvt_pk_bf16(v0[2], v0[3]); w.z = cvt_pk_bf16(v1[0], v1[1]); w.w = cvt_pk_bf16(v1[2], v1[3]);
                    *(u32x4*)(rowp + bj * HALF) = w; } }
    }
};
struct EpiQKV {
    static constexpr bool PERM = true;
    bf16_t* Q; bf16_t* K; bf16_t* V; const float* tabc; const float* tabs; const float* gq; const float* gk; const float* ss; const float* bias;
    __device__ __forceinline__ void operator()(f32x4 (&acc)[2][2][4][2], const Unit& u, int wr, int wc, int fr, int fq, PG8_LAS unsigned char* lds) const {
        asm volatile("" : "+v"(fr), "+v"(fq));
        const bool lat = u.pm < (ML / BM);
        {
            const float* bq = bias + (size_t)(lat ? (u.pm >> 4) : 8) * NQKV + u.pn * BM + wc * 32 + 8 * fq;
            const f32x4 b00 = *(const f32x4*)bq, b01 = *(const f32x4*)(bq + 4), b10 = *(const f32x4*)(bq + HALF), b11 = *(const f32x4*)(bq + HALF + 4);
            const float* sr = ss + u.pm * BM + wr * 64 + fr;
#pragma unroll
            for (int ai = 0; ai < 2; ++ai)
#pragma unroll
                for (int m = 0; m < 4; ++m) { const float r = __builtin_amdgcn_rsqf(sr[ai * HALF + m * 16] * (1.0f / DM) + EPS);
                    acc[ai][0][m][0] = acc[ai][0][m][0] * r + b00; acc[ai][0][m][1] = acc[ai][0][m][1] * r + b01; acc[ai][1][m][0] = acc[ai][1][m][0] * r + b10; acc[ai][1][m][1] = acc[ai][1][m][1] * r + b11; }
        }
        const int b = lat ? (u.pm >> 4) : (u.pm - ML / BM);
        const int t0 = wc * 32 + 8 * fq;
        const int rl0 = wr * 64 + fr;
        if (u.pn >= 10) {
#pragma unroll
            for (int ai = 0; ai < 2; ++ai)
#pragma unroll
                for (int m = 0; m < 4; ++m) { const int rl = rl0 + ai * HALF + m * 16; const int kvrow = lat ? (CTXL + (u.pm & 15) * 256 + rl) : rl;
#pragma unroll
                    for (int bj = 0; bj < 2; ++bj) { const int kvh = 2 * (u.pn - 10) + bj; const f32x4 v0 = acc[ai][bj][m][0], v1 = acc[ai][bj][m][1];
                        u32x4 w; w.x = cvt_pk_bf16(v0[0], v0[1]); w.y = cvt_pk_bf16(v0[2], v0[3]); w.z = cvt_pk_bf16(v1[0], v1[1]); w.w = cvt_pk_bf16(v1[2], v1[3]);
                        *(u32x4*)(V + ((size_t)(b * NKV + kvh) * SKV + kvrow) * HD + t0) = w; } }
            return;
        }
        PG8_LAS float* T = (PG8_LAS float*)(lds + XCH_OFF);
        const bool isq = u.pn < 8;
        const float* gv = isq ? gq : gk;
        const f32x4 ga = *(const f32x4*)(gv + t0), gb = *(const f32x4*)(gv + t0 + 4);
        const int f0 = 16 * (wc & 1) + 4 * fq;
        f32x4 csv[2][4], snv[2][4];
#pragma unroll
        for (int ai = 0; ai < 2; ++ai)
#pragma unroll
            for (int m = 0; m < 4; ++m) { csv[ai][m] = (f32x4){1.f, 1.f, 1.f, 1.f}; snv[ai][m] = (f32x4){0.f, 0.f, 0.f, 0.f};
                if (lat) { const int s = (u.pm & 15) * 256 + rl0 + ai * HALF + m * 16; const int pos = (wc >> 1) ? (s & 63) : (s >> 6);
                    csv[ai][m] = *(const f32x4*)(tabc + pos * 32 + f0); snv[ai][m] = *(const f32x4*)(tabs + pos * 32 + f0); } }
#pragma unroll
        for (int ai = 0; ai < 2; ++ai)
#pragma unroll
            for (int m = 0; m < 4; ++m)
#pragma unroll
                for (int bj = 0; bj < 2; ++bj) { const f32x4 v0 = acc[ai][bj][m][0], v1 = acc[ai][bj][m][1];
                    float s = (v0[0] * v0[0] + v0[1] * v0[1]) + (v0[2] * v0[2] + v0[3] * v0[3]) + (v1[0] * v1[0] + v1[1] * v1[1]) + (v1[2] * v1[2] + v1[3] * v1[3]);
                    s += __shfl_xor(s, 16); s += __shfl_xor(s, 32);
                    if (fq == 0) T[(rl0 + ai * HALF + m * 16) * 8 + bj * 4 + wc] = s; }
        asm volatile("s_waitcnt lgkmcnt(0)" ::: "memory"); __builtin_amdgcn_s_barrier(); asm volatile("" ::: "memory");
#pragma unroll
        for (int ai = 0; ai < 2; ++ai)
#pragma unroll
            for (int m = 0; m < 4; ++m) { const int rl = rl0 + ai * HALF + m * 16;
                const f32x4 cs = csv[ai][m], sn = snv[ai][m];
#pragma unroll
                for (int bj = 0; bj < 2; ++bj) {
                    const f32x4 p4 = *(const PG8_LAS f32x4*)(T + rl * 8 + bj * 4);
                    const float rstd = 1.0f / sqrtf(((p4[0] + p4[1]) + (p4[2] + p4[3])) * (1.0f / 128.0f) + EPS);
                    const f32x4 y0 = acc[ai][bj][m][0] * rstd * ga, y1 = acc[ai][bj][m][1] * rstd * gb;
                    const float a0 = y0[0] * cs[0] - y0[1] * sn[0], a1 = y0[1] * cs[0] + y0[0] * sn[0];
                    const float a2 = y0[2] * cs[1] - y0[3] * sn[1], a3 = y0[3] * cs[1] + y0[2] * sn[1];
                    const float a4 = y1[0] * cs[2] - y1[1] * sn[2], a5 = y1[1] * cs[2] + y1[0] * sn[2];
                    const float a6 = y1[2] * cs[3] - y1[3] * sn[3], a7 = y1[3] * cs[3] + y1[2] * sn[3];
                    u32x4 w; w.x = cvt_pk_bf16(a0, a1); w.y = cvt_pk_bf16(a2, a3); w.z = cvt_pk_bf16(a4, a5); w.w = cvt_pk_bf16(a6, a7);
                    if (isq) { const int h = 2 * u.pn + bj; *(u32x4*)(Q + (size_t)(u.pm * BM + rl) * DM + h * HD + t0) = w; }
                    else { const int kvh = 2 * (u.pn - 8) + bj; const int kvrow = lat ? (CTXL + (u.pm & 15) * 256 + rl) : rl;
                        *(u32x4*)(K + ((size_t)(b * NKV + kvh) * SKV + kvrow) * HD + t0) = w; }
                } }
    }
};

template <class Epi, class Sched, bool ALIGN_EPI, bool SP2, int MODE = 0>
__device__ __forceinline__ void gemm_phase(PG8_LAS unsigned char* lds, const int lda, const int ldb, const Sched& S, const Epi& E, const int wave, const int first = 0, float* stag_slab = nullptr) {
    int tid_ = wave * 64 + lane_id_fresh(); asm volatile("" : "+v"(tid_));
    const int tid = tid_, wid = __builtin_amdgcn_readfirstlane(tid >> 6), lane = tid & 63, wr = wid >> 2, wc = wid & 3, fr = lane & 15, fq = lane >> 4;
    unsigned voffA[2], voffB[2];
#pragma unroll
    for (int i = 0; i < 2; ++i) { int R, C; stage_rc(tid * 16 + i * 8192, R, C); const int Rb = Epi::PERM ? ((R & ~31) + perm32(R & 31)) : R;
        voffA[i] = (unsigned)(R * lda + C) * 2u; voffB[i] = (unsigned)(Rb * ldb + C) * 2u; }
    const size_t kstep = (size_t)(BK * 2);
    const size_t hstepA = (size_t)HALF * lda * 2, hstepB = (size_t)HALF * ldb * 2;
    const unsigned ldsw = (unsigned)wid * 1024u;
    const int aoff = lds_byte(wr * 64 + fr, fq * 8), boff = lds_byte(wc * 32 + fr, fq * 8);
#define PG8_SA(b, h) (((b) * 2 + (h)) * HTB)
#define PG8_SB(b, h) ((4 + (b) * 2 + (h)) * HTB)
#define PG8_STAGE(bufoff, gbase, voff) do { const __amdgpu_buffer_rsrc_t r_ = __builtin_amdgcn_make_buffer_rsrc((void*)(gbase), 0, 0x7fffffff, 0x00020000); _Pragma("unroll") for (int _i = 0; _i < 2; ++_i) \
        __builtin_amdgcn_raw_ptr_buffer_load_lds(r_, (PG8_LAS void*)(lds + (bufoff) + ldsw + _i * 8192), 16, (voff)[_i], 0, 0, 0); } while (0)
#define PG8_LDA(dst, b, h) do { _Pragma("unroll") for (int m = 0; m < 4; ++m) _Pragma("unroll") for (int k = 0; k < 2; ++k) dst[m][k] = *(const PG8_LAS bf16x8*)(lds + PG8_SA(b, h) + aoff + m * 2048 + k * 1024); } while (0)
#define PG8_LDB(dst, b, h) do { _Pragma("unroll") for (int n = 0; n < 2; ++n) _Pragma("unroll") for (int k = 0; k < 2; ++k) dst[n][k] = *(const PG8_LAS bf16x8*)(lds + PG8_SB(b, h) + boff + n * 2048 + k * 1024); } while (0)
#define PG8_MMA(ai, bj, At, Bt) do { __builtin_amdgcn_s_setprio(1); _Pragma("unroll") for (int m = 0; m < 4; ++m) _Pragma("unroll") for (int n = 0; n < 2; ++n) _Pragma("unroll") for (int k = 0; k < 2; ++k) \
        acc[ai][bj][m][n] = __builtin_amdgcn_mfma_f32_16x16x32_bf16(Bt[n][k], At[m][k], acc[ai][bj][m][n], 0, 0, 0); __builtin_amdgcn_s_setprio(0); } while (0)
#define PG8_WAIT_V(n) asm volatile("s_waitcnt vmcnt(" #n ")" ::: "memory")
#define PG8_WAIT_L(n) asm volatile("s_waitcnt lgkmcnt(" #n ")" ::: "memory")
#define PG8_BAR __builtin_amdgcn_s_barrier()
#define PG8_SCHED __builtin_amdgcn_sched_barrier(0)
    Unit cur, nxt; int ui = first;
    if (!S.next(first, cur)) return;
    f32x4 acc[2][2][4][2];
#pragma unroll
    for (int a = 0; a < 2; ++a)
#pragma unroll
        for (int b = 0; b < 2; ++b)
#pragma unroll
            for (int m = 0; m < 4; ++m)
#pragma unroll
                for (int n = 0; n < 2; ++n) {
                    if constexpr (MODE == 2) acc[a][b][m][n] = __builtin_nontemporal_load((const f32x4*)((const char*)stag_slab + (size_t)((unsigned)(wid * 32768 + lane * 16) + (unsigned)((((a * 2 + b) * 4 + m) * 2 + n) * 1024))));
                    else acc[a][b][m][n] = (f32x4){0.f, 0.f, 0.f, 0.f}; }
    bf16x8 At[4][2], B0[2][2], B1[2][2];
    const char* cA = cur.A; const char* cB = cur.B;
    if constexpr (SP2) {
        PG8_STAGE(PG8_SB(0, 0), cB, voffB); PG8_STAGE(PG8_SB(0, 1), cB + hstepB, voffB); PG8_STAGE(PG8_SA(0, 0), cA, voffA); PG8_STAGE(PG8_SA(0, 1), cA + hstepA, voffA);
        if (wr == 1) PG8_BAR;
        PG8_WAIT_V(2); PG8_BAR;
        PG8_STAGE(PG8_SB(1, 0), cB + kstep, voffB); PG8_STAGE(PG8_SA(1, 0), cA + kstep, voffA); PG8_STAGE(PG8_SB(1, 1), cB + hstepB + kstep, voffB);
        PG8_WAIT_V(6); PG8_BAR;
    } else {
        PG8_STAGE(PG8_SB(0, 0), cB, voffB); PG8_STAGE(PG8_SA(0, 0), cA, voffA); PG8_STAGE(PG8_SB(0, 1), cB + hstepB, voffB); PG8_STAGE(PG8_SA(0, 1), cA + hstepA, voffA);
        if (wr == 1) PG8_BAR;
        PG8_WAIT_V(4); PG8_BAR;
        PG8_STAGE(PG8_SB(1, 0), cB + kstep, voffB); PG8_STAGE(PG8_SA(1, 0), cA + kstep, voffA); PG8_STAGE(PG8_SB(1, 1), cB + hstepB + kstep, voffB);
        PG8_WAIT_V(6); PG8_BAR;
    }
    for (;;) {
        const bool has_next = S.next(ui + 1, nxt);
        const char* nA = has_next ? nxt.A : cA; const char* nB = has_next ? nxt.B : cB;
        const int nt = cur.nt;
        for (int t = 0; t < nt; t += 2) {
            const bool last = (t == nt - 2);
            const char* a1 = cA + (size_t)(t + 1) * kstep;
            const char* a2 = last ? nA : cA + (size_t)(t + 2) * kstep; const char* b2 = last ? nB : cB + (size_t)(t + 2) * kstep;
            const char* a3 = a2 + kstep; const char* b3 = b2 + kstep;
            if constexpr (SP2) {
            PG8_LDB(B0, 0, 0); PG8_LDB(B1, 0, 1); PG8_SCHED; PG8_LDA(At, 0, 0); PG8_STAGE(PG8_SA(1, 1), a1 + hstepA, voffA);
            PG8_WAIT_V(8); PG8_WAIT_L(0); PG8_BAR; PG8_MMA(0, 0, At, B0); PG8_MMA(0, 1, At, B1); PG8_BAR; PG8_SCHED;
            PG8_LDA(At, 0, 1); PG8_STAGE(PG8_SB(0, 0), b2, voffB); PG8_STAGE(PG8_SB(0, 1), b2 + hstepB, voffB); PG8_STAGE(PG8_SA(0, 0), a2, voffA);
            PG8_WAIT_V(8); PG8_WAIT_L(0); PG8_BAR; PG8_MMA(1, 0, At, B0); PG8_MMA(1, 1, At, B1); PG8_BAR; PG8_SCHED;
            PG8_LDB(B0, 1, 0); PG8_LDB(B1, 1, 1); PG8_SCHED; PG8_LDA(At, 1, 0); PG8_STAGE(PG8_SA(0, 1), a2 + hstepA, voffA);
            PG8_WAIT_V(8); PG8_WAIT_L(0); PG8_BAR; PG8_MMA(0, 0, At, B0); PG8_MMA(0, 1, At, B1); PG8_BAR; PG8_SCHED;
            PG8_LDA(At, 1, 1); PG8_STAGE(PG8_SB(1, 0), b3, voffB); PG8_STAGE(PG8_SB(1, 1), b3 + hstepB, voffB); PG8_STAGE(PG8_SA(1, 0), a3, voffA);
            PG8_WAIT_V(8); PG8_WAIT_L(0); PG8_BAR; PG8_MMA(1, 0, At, B0); PG8_MMA(1, 1, At, B1); PG8_BAR; PG8_SCHED;
            } else {
            PG8_LDB(B0, 0, 0); PG8_SCHED; PG8_LDA(At, 0, 0); PG8_STAGE(PG8_SA(1, 1), a1 + hstepA, voffA);
            PG8_WAIT_L(8); PG8_BAR; PG8_WAIT_L(0); PG8_MMA(0, 0, At, B0); PG8_BAR; PG8_SCHED;
            PG8_LDB(B1, 0, 1); PG8_STAGE(PG8_SB(0, 0), b2, voffB);
            PG8_BAR; PG8_WAIT_L(0); PG8_MMA(0, 1, At, B1); PG8_BAR;
            PG8_LDA(At, 0, 1); PG8_STAGE(PG8_SA(0, 0), a2, voffA);
            PG8_BAR; PG8_WAIT_L(0); PG8_MMA(1, 0, At, B0); PG8_BAR; PG8_SCHED;
            PG8_STAGE(PG8_SB(0, 1), b2 + hstepB, voffB);
            PG8_WAIT_V(6); PG8_BAR; PG8_MMA(1, 1, At, B1); PG8_BAR;
            PG8_LDB(B0, 1, 0); PG8_SCHED; PG8_LDA(At, 1, 0); PG8_STAGE(PG8_SA(0, 1), a2 + hstepA, voffA);
            PG8_WAIT_L(8); PG8_BAR; PG8_WAIT_L(0); PG8_MMA(0, 0, At, B0); PG8_BAR; PG8_SCHED;
            PG8_LDB(B1, 1, 1); PG8_STAGE(PG8_SB(1, 0), b3, voffB);
            PG8_BAR; PG8_WAIT_L(0); PG8_MMA(0, 1, At, B1); PG8_BAR;
            PG8_LDA(At, 1, 1); PG8_STAGE(PG8_SA(1, 0), a3, voffA);
            PG8_BAR; PG8_WAIT_L(0); PG8_MMA(1, 0, At, B0); PG8_BAR; PG8_SCHED;
            PG8_STAGE(PG8_SB(1, 1), b3 + hstepB, voffB);
            PG8_WAIT_V(6); PG8_BAR; PG8_MMA(1, 1, At, B1); PG8_BAR;
            }
        }
        if constexpr (ALIGN_EPI) { if (wr == 0) PG8_BAR; }
        if constexpr (MODE == 1) { unsigned svo = (unsigned)(wid * 32768 + lane_id_fresh() * 16); asm volatile("" : "+v"(svo));
#pragma unroll
            for (int a = 0; a < 2; ++a)
#pragma unroll
                for (int b = 0; b < 2; ++b)
#pragma unroll
                    for (int m = 0; m < 4; ++m)
#pragma unroll
                        for (int n = 0; n < 2; ++n) *(f32x4*)((char*)stag_slab + (size_t)(svo + (unsigned)((((a * 2 + b) * 4 + m) * 2 + n) * 1024))) = acc[a][b][m][n];
        } else { const int le = lane_id_fresh(); E(acc, cur, wr, wc, le & 15, le >> 4, lds); }
        if (!has_next) break;
#pragma unroll
        for (int a = 0; a < 2; ++a)
#pragma unroll
            for (int b = 0; b < 2; ++b)
#pragma unroll
                for (int m = 0; m < 4; ++m)
#pragma unroll
                    for (int n = 0; n < 2; ++n) acc[a][b][m][n] = (f32x4){0.f, 0.f, 0.f, 0.f};
        cur = nxt; cA = nA; cB = nB; ++ui;
        if constexpr (ALIGN_EPI) { if (wr == 1) PG8_BAR; }
    }
    PG8_WAIT_V(0);
    if constexpr (!ALIGN_EPI) { if (wr == 0) PG8_BAR; }
    PG8_BAR;
#undef PG8_SA
#undef PG8_SB
#undef PG8_STAGE
#undef PG8_LDA
#undef PG8_LDB
#undef PG8_MMA
#undef PG8_WAIT_V
#undef PG8_WAIT_L
#undef PG8_BAR
#undef PG8_SCHED
}
struct OneUnit { Unit u; __device__ __forceinline__ bool next(int i, Unit& o) const { if (i != 0) return false; o = u; return true; } };
template <class Epi, class Sched, bool ALIGN_EPI, bool SP2>
__device__ __forceinline__ void gemm_phase_stag(PG8_LAS unsigned char* lds, const int lda, const int ldb, const Sched& S, const Epi& E, const int wave, float* stag_slab, bool stag) {
    if (stag) { Unit t; if (!S.next(0, t) || t.split != 0 || (t.nt & 3) != 0 || t.nt < 8) stag = false; }
    if (stag) { OneUnit s1; (void)S.next(0, s1.u); s1.u.nt >>= 1; gemm_phase<Epi, OneUnit, ALIGN_EPI, SP2, 1>(lds, lda, ldb, s1, E, wave, 0, stag_slab); }
    gemm_phase<Epi, Sched, ALIGN_EPI, SP2, 0>(lds, lda, ldb, S, E, wave, stag ? 1 : 0, stag_slab);
    if (stag) { OneUnit s2; (void)S.next(0, s2.u); const int h = s2.u.nt >> 1; s2.u.A += (size_t)h * (BK * 2); s2.u.B += (size_t)h * (BK * 2); s2.u.nt -= h;
        gemm_phase<Epi, OneUnit, ALIGN_EPI, SP2, 2>(lds, lda, ldb, s2, E, wave, 0, stag_slab); }
}
}

namespace att {
using bf16x8 = __attribute__((ext_vector_type(8))) short;
using s16x4  = __attribute__((ext_vector_type(4))) short;
using f32x16 = __attribute__((ext_vector_type(16))) float;
using u32x4  = __attribute__((ext_vector_type(4))) unsigned;
constexpr int D = 128, NW = 8, QBLK = 32, KVBLK = 64;
constexpr float SCALE = 0.088388347648318440f;
constexpr float THR = 8.f;
#ifndef ATTN_SDEPTH
#define ATTN_SDEPTH 1
#endif
constexpr int SDEPTH = ATTN_SDEPTH;
constexpr int LDQ = DM, LDK = HD, LDO = DM;
constexpr size_t SHM_V = KVBLK * D * 2, SHM_K = KVBLK * D * 2, SHM_ATTN = 2 * SHM_V + 2 * SHM_K + NW * 64 * 4;
#define KSWZ(row, colB) ((row) * 256 + ((colB) ^ (((row) & 7) << 4)))
#define SBAR() __builtin_amdgcn_sched_barrier(0)
__device__ __forceinline__ int crow(int r, int hi) { return (r & 3) + 8 * (r >> 2) + 4 * hi; }
__device__ __forceinline__ unsigned cvtpk(float lo, float hi) { unsigned r; asm volatile("v_cvt_pk_bf16_f32 %0, %1, %2" : "=v"(r) : "v"(lo), "v"(hi)); return r; }
__device__ __forceinline__ void partialSM(f32x16& p0, f32x16& p1, float& m_reg, float& mn, float& alpha) {
  constexpr float C = SCALE * 1.4426950408889634f;
  float pmax = p0[0]; for (int r = 1; r < 16; ++r) pmax = fmaxf(pmax, p0[r]); for (int r = 0; r < 16; ++r) pmax = fmaxf(pmax, p1[r]);
  { auto rr = __builtin_amdgcn_permlane32_swap(__float_as_uint(pmax), __float_as_uint(pmax), false, false);
    pmax = fmaxf(__uint_as_float(rr[0]), __uint_as_float(rr[1])); }
  if (__builtin_expect(__all(pmax - m_reg <= THR / SCALE), 1)) { mn = m_reg; alpha = 1.f; }
  else { mn = fmaxf(m_reg, pmax); alpha = __builtin_amdgcn_exp2f((m_reg - mn) * C); m_reg = mn; }
  float mnC = -mn * C;
  for (int r = 0; r < 16; ++r) p0[r] = fmaf(p0[r], C, mnC); for (int r = 0; r < 16; ++r) p1[r] = fmaf(p1[r], C, mnC);
  for (int r = 0; r < 16; ++r) p0[r] = __builtin_amdgcn_exp2f(p0[r]);
}
__device__ __forceinline__ void finishSM(f32x16& p0, f32x16& p1, float alpha, float& l_reg, bf16x8& pa0, bf16x8& pa1, bf16x8& pa2, bf16x8& pa3) {
  for (int r = 0; r < 16; ++r) p1[r] = __builtin_amdgcn_exp2f(p1[r]);
  float ps = 0; for (int r = 0; r < 16; ++r) ps += p0[r]; for (int r = 0; r < 16; ++r) ps += p1[r];
  { auto rr = __builtin_amdgcn_permlane32_swap(__float_as_uint(ps), __float_as_uint(ps), false, false);
    ps = __uint_as_float(rr[0]) + __uint_as_float(rr[1]); }
  l_reg = l_reg * alpha + ps;
#define PK4(P, BASE, OUT) do { unsigned a0 = cvtpk(P[BASE + 0], P[BASE + 1]), a1 = cvtpk(P[BASE + 2], P[BASE + 3]);   \
    unsigned b0 = cvtpk(P[BASE + 4], P[BASE + 5]), b1 = cvtpk(P[BASE + 6], P[BASE + 7]);                              \
    auto r0 = __builtin_amdgcn_permlane32_swap(a0, b0, false, false); auto r1 = __builtin_amdgcn_permlane32_swap(a1, b1, false, false); \
    u32x4 w = {r0[0], r1[0], r0[1], r1[1]}; OUT = *reinterpret_cast<bf16x8*>(&w); } while (0)
  PK4(p0, 0, pa0); PK4(p0, 8, pa1); PK4(p1, 0, pa2); PK4(p1, 8, pa3);
#undef PK4
}
__device__ __forceinline__ void qkt(f32x16& p0, f32x16& p1, const bf16* Ks, const bf16x8* qr, int r32, int hi) {
  p0 = f32x16{}; p1 = f32x16{};
  for (int d0 = 0; d0 < 8; ++d0) { int cb = (d0 * 16 + hi * 8) * 2;
    bf16x8 b0 = *reinterpret_cast<const bf16x8*>((const char*)Ks + KSWZ(r32, cb));
    bf16x8 b1 = *reinterpret_cast<const bf16x8*>((const char*)Ks + KSWZ(32 + r32, cb));
    p0 = __builtin_amdgcn_mfma_f32_32x32x16_bf16(b0, qr[d0], p0, 0, 0, 0);
    p1 = __builtin_amdgcn_mfma_f32_32x32x16_bf16(b1, qr[d0], p1, 0, 0, 0); }
}
__device__ __forceinline__ int v_st(int k, int c) { const int kk = (k & ~0xC) | ((k & 4) << 1) | ((k & 8) >> 1); return ((kk >> 3) * 4 + (c >> 5)) * 512 + ((kk & 7) * 32 + (c & 31)) * 2; }
__device__ __forceinline__ int v_rd_base(int lane) { return ((lane & 3) << 3) | (((lane >> 2) & 3) << 6) | (((lane >> 4) & 1) << 5) | (((lane >> 5) & 1) << 8); }
constexpr int v_rd_off(int d0, int ks, int half) { return d0 * 512 + ks * 4096 + half * 2048; }
template <int OFF> __device__ __forceinline__ s16x4 tr_read(int vb) {
  s16x4 r; asm volatile("ds_read_b64_tr_b16 %0, %1 offset:%2" : "=&v"(r) : "v"(vb), "i"(OFF) : "memory"); return r;
}
template <int D0> __device__ __forceinline__ void pv_one(f32x16& od, int vb, bf16x8 pa0, bf16x8 pa1, bf16x8 pa2, bf16x8 pa3) {
  const s16x4 l0 = tr_read<v_rd_off(D0, 0, 0)>(vb), h0 = tr_read<v_rd_off(D0, 0, 1)>(vb), l1 = tr_read<v_rd_off(D0, 1, 0)>(vb), h1 = tr_read<v_rd_off(D0, 1, 1)>(vb);
  const s16x4 l2 = tr_read<v_rd_off(D0, 2, 0)>(vb), h2 = tr_read<v_rd_off(D0, 2, 1)>(vb), l3 = tr_read<v_rd_off(D0, 3, 0)>(vb), h3 = tr_read<v_rd_off(D0, 3, 1)>(vb);
  asm volatile("s_waitcnt lgkmcnt(0)" ::: "memory"); SBAR();
#define PK(L, H) (bf16x8){L[0], L[1], L[2], L[3], H[0], H[1], H[2], H[3]}
  od = __builtin_amdgcn_mfma_f32_32x32x16_bf16(pa0, PK(l0, h0), od, 0, 0, 0);
  od = __builtin_amdgcn_mfma_f32_32x32x16_bf16(pa1, PK(l1, h1), od, 0, 0, 0);
  od = __builtin_amdgcn_mfma_f32_32x32x16_bf16(pa2, PK(l2, h2), od, 0, 0, 0);
  od = __builtin_amdgcn_mfma_f32_32x32x16_bf16(pa3, PK(l3, h3), od, 0, 0, 0);
#undef PK
}
__device__ __forceinline__ void pv_d0(f32x16* o, int vb, bf16x8 pa0, bf16x8 pa1, bf16x8 pa2, bf16x8 pa3) {
  pv_one<0>(o[0], vb, pa0, pa1, pa2, pa3); pv_one<1>(o[1], vb, pa0, pa1, pa2, pa3); pv_one<2>(o[2], vb, pa0, pa1, pa2, pa3); pv_one<3>(o[3], vb, pa0, pa1, pa2, pa3);
}
__device__ __forceinline__ void attn_dense_body(const bf16* __restrict__ Qb, const bf16* __restrict__ Kh, const bf16* __restrict__ Vh, bf16* __restrict__ Ob, int seq, char* lds, const int wave) {
  int tid_ = wave * 64 + lane_id_fresh(); asm volatile("" : "+v"(tid_));
  const int tid = tid_, wid = tid >> 6, lane = tid & 63, r32 = lane & 31, hi = lane >> 5;
  bf16* V_lds = (bf16*)lds; bf16* K_lds = (bf16*)(lds + 2 * SHM_V);
  float* ws = (float*)(lds + 2 * SHM_V + 2 * SHM_K) + wid * 64; float* li_l = ws; float* al_l = ws + 32;
  float m_reg = -1e30f, l_reg = 0; f32x16 o[4] = {}; bf16x8 qr[8];
  const bf16* Qw = Qb + (long)(wid * QBLK + r32) * LDQ + hi * 8;
#pragma unroll
  for (int d0 = 0; d0 < 8; ++d0) qr[d0] = *reinterpret_cast<const bf16x8*>(Qw + d0 * 16);
  const int sr = tid >> 4, sc = (tid & 15) * 8, vst0 = v_st(sr, sc), vst1 = v_st(32 + sr, sc);
  const int vb0 = (int)(uintptr_t)V_lds + v_rd_base(lane);
  struct { bf16x8 vs0, vs1, ks0, ks1; } sr_[SDEPTH];
#define LD8(p) (*reinterpret_cast<const bf16x8*>(p))
#define SLOAD(i, k0) do { sr_[i].vs0 = LD8(&Vh[(long)((k0) + sr) * LDK + sc]); sr_[i].vs1 = LD8(&Vh[(long)((k0) + 32 + sr) * LDK + sc]); \
    sr_[i].ks0 = LD8(&Kh[(long)((k0) + sr) * LDK + sc]); sr_[i].ks1 = LD8(&Kh[(long)((k0) + 32 + sr) * LDK + sc]); } while (0)
#define SWRITE(b, i) do { *(bf16x8*)((char*)V_lds + (b) * SHM_V + vst0) = sr_[i].vs0;          \
    *(bf16x8*)((char*)V_lds + (b) * SHM_V + vst1) = sr_[i].vs1; int kc = sc * 2;               \
    *(bf16x8*)((char*)K_lds + (b) * SHM_K + KSWZ(sr, kc)) = sr_[i].ks0;                       \
    *(bf16x8*)((char*)K_lds + (b) * SHM_K + KSWZ(32 + sr, kc)) = sr_[i].ks1; } while (0)
#define SWAIT() do { if constexpr (SDEPTH == 2) asm volatile("s_waitcnt vmcnt(4)" ::: "memory"); else asm volatile("s_waitcnt vmcnt(0)" ::: "memory"); } while (0)
#define RESC(a) do { if (__any((a) < 1.f)) { if (hi == 0) al_l[r32] = (a); asm volatile("s_waitcnt lgkmcnt(0)" ::: "memory"); \
    for (int d = 0; d < 4; ++d) for (int r = 0; r < 16; ++r) o[d][r] *= al_l[crow(r, hi)]; } } while (0)
  f32x16 pA0, pA1, pB0, pB1; float mnA, mnB, alA, alB; bf16x8 pa0, pa1, pa2, pa3; const int NT = seq / KVBLK;
  constexpr int SE = 0, SO = SDEPTH - 1;
  SLOAD(SE, 0); asm volatile("s_waitcnt vmcnt(0)" ::: "memory"); SWRITE(0, SE); __syncthreads();
  qkt(pA0, pA1, K_lds, qr, r32, hi); partialSM(pA0, pA1, m_reg, mnA, alA);
  SLOAD(SO, KVBLK); if constexpr (SDEPTH == 2) { if (2 < NT) SLOAD(SE, 2 * KVBLK); }
  SWAIT(); SWRITE(1, SO); __syncthreads();
  for (int j = 1; j + 1 < NT; j += 2) {
    SBAR(); qkt(pB0, pB1, (bf16*)((char*)K_lds + SHM_K), qr, r32, hi);
    finishSM(pA0, pA1, alA, l_reg, pa0, pa1, pa2, pa3); SBAR();
    SLOAD(SO, (j + SDEPTH) * KVBLK); SBAR();
    pv_d0(o, vb0, pa0, pa1, pa2, pa3); partialSM(pB0, pB1, m_reg, mnB, alB);
    __syncthreads(); SWAIT(); SWRITE(0, SE);
    RESC(alB); __syncthreads();
    SBAR(); qkt(pA0, pA1, K_lds, qr, r32, hi);
    finishSM(pB0, pB1, alB, l_reg, pa0, pa1, pa2, pa3); SBAR();
    if (SDEPTH == 1 || j + 3 < NT) SLOAD(SE, (j + 1 + SDEPTH) * KVBLK); SBAR();
    pv_d0(o, vb0 + (int)SHM_V, pa0, pa1, pa2, pa3); partialSM(pA0, pA1, m_reg, mnA, alA);
    __syncthreads(); SWAIT(); SWRITE(1, SO);
    RESC(alA); __syncthreads();
  }
  SBAR(); qkt(pB0, pB1, (bf16*)((char*)K_lds + SHM_K), qr, r32, hi);
  finishSM(pA0, pA1, alA, l_reg, pa0, pa1, pa2, pa3); SBAR();
  pv_d0(o, vb0, pa0, pa1, pa2, pa3); partialSM(pB0, pB1, m_reg, mnB, alB);
  __syncthreads(); RESC(alB);
  finishSM(pB0, pB1, alB, l_reg, pa0, pa1, pa2, pa3); SBAR();
  pv_d0(o, vb0 + (int)SHM_V, pa0, pa1, pa2, pa3);
  { const int l2 = lane_id(), r32e = l2 & 31, hie = l2 >> 5;
  if (hie == 0) li_l[r32e] = l_reg; asm volatile("s_waitcnt lgkmcnt(0)" ::: "memory");
  float rli[16];
#pragma unroll
  for (int r = 0; r < 16; ++r) rli[r] = __builtin_amdgcn_rcpf(li_l[crow(r, hie)]);
  char* ost = lds + 2 * SHM_V + 2 * SHM_K + NW * 64 * 4 + wid * (32 * 272);
#pragma unroll
  for (int r = 0; r < 16; ++r) { const int orow = crow(r, hie);
#pragma unroll
    for (int d0 = 0; d0 < 4; ++d0) *(bf16*)(ost + orow * 272 + (d0 * 32 + r32e) * 2) = (bf16)f2bf(o[d0][r] * rli[r]); }
  asm volatile("s_waitcnt lgkmcnt(0)" ::: "memory");
  bf16* Ow = Ob + (long)(wid * QBLK) * LDO;
#pragma unroll
  for (int i = 0; i < 8; ++i) { const int ch = i * 64 + l2, orow = ch >> 4, c8 = (ch & 15) * 8;
    *reinterpret_cast<u32x4*>(Ow + (long)orow * LDO + c8) = *reinterpret_cast<const u32x4*>(ost + orow * 272 + c8 * 2); } }
  __syncthreads();
#undef LD8
#undef SLOAD
#undef SWRITE
#undef SWAIT
#undef RESC
}
}

#define XB_TMO      128
#define XB_XCNT(j)  (256  + 64 * (j))
#define XB_XSUB(j)  (1280 + 64 * (j))
#define XB_XGEN(j)  (2304 + 64 * (j))
#define XB_TOP      3328
#define XB_TOPGEN   3392
#define XCD_BAR_WORDS 3456
#define XB_SPIN_CAP (1u << 18)
__device__ __forceinline__ unsigned xb_ld(unsigned* p)              { return __hip_atomic_load(p, __ATOMIC_RELAXED, __HIP_MEMORY_SCOPE_AGENT); }
__device__ __forceinline__ unsigned xb_add(unsigned* p, unsigned v) { return __hip_atomic_fetch_add(p, v, __ATOMIC_RELAXED, __HIP_MEMORY_SCOPE_AGENT); }
__device__ __forceinline__ unsigned xb_xcc_id() { return (unsigned)__builtin_amdgcn_s_getreg((3 << 11) | 20) & 0xFu; }
#define XB_SPIN(cond, bar) do { unsigned _sp = 0; while (cond) { __builtin_amdgcn_s_sleep(1); \
    if ((++_sp & 255u) == 0u) { if (xb_ld(&(bar)[XB_TMO])) break; if (_sp > XB_SPIN_CAP) { atomicAdd(&(bar)[XB_TMO], 1u); break; } } } } while (0)
struct XcdBarrier { unsigned* bar; unsigned x; volatile LAS unsigned* st; int wave; };
__device__ __forceinline__ XcdBarrier xcd_barrier_post(unsigned* bar, volatile LAS unsigned* st, int wave) {
    XcdBarrier b; b.bar = bar; b.x = xb_xcc_id(); b.st = st; b.wave = wave;
    if (wave == 0 && lane_id() == 0) (void)xb_add(&bar[XB_XCNT(b.x)], 1u);
    return b;
}
__device__ __forceinline__ void xcd_barrier_complete(unsigned* bar, unsigned x, unsigned& nloc, unsigned& nx) {
    const unsigned G = gridDim.x * gridDim.y * gridDim.z;
    unsigned sum, cnt, mine, sp = 0u;
    for (;;) {
        sum = 0u; cnt = 0u; mine = 0u;
#pragma unroll
        for (unsigned j = 0; j < 16; ++j) { const unsigned c = xb_ld(&bar[XB_XCNT(j)]); sum += c; cnt += (c > 0u) ? 1u : 0u; mine = (j == x) ? c : mine; }
        if (sum == G) break;
        __builtin_amdgcn_s_sleep(1);
        if ((++sp & 255u) == 0u) { if (xb_ld(&bar[XB_TMO])) break; if (sp > XB_SPIN_CAP) { atomicAdd(&bar[XB_TMO], 1u); break; } }
    }
    nloc = mine > 0u ? mine : 1u; nx = cnt > 0u ? cnt : 1u;
}
__device__ __forceinline__ void xcd_barrier(const XcdBarrier& b) {
    asm volatile("s_waitcnt vmcnt(0)" ::: "memory");
    __syncthreads();
    if (b.wave == 0 && lane_id() == 0) {
        unsigned* bar = b.bar;
        __builtin_amdgcn_s_waitcnt(0);
        unsigned nloc = b.st[0], nx = b.st[1];
        if (nloc == 0u) { xcd_barrier_complete(bar, b.x, nloc, nx); b.st[0] = nloc; b.st[1] = nx; }
        const unsigned old = xb_add(&bar[XB_XSUB(b.x)], 1u);
        const unsigned gen = old / nloc;
        if (old + 1u == (gen + 1u) * nloc) {
            __builtin_amdgcn_fence(__ATOMIC_RELEASE, "agent");
            asm volatile("s_waitcnt vmcnt(0)" ::: "memory");
            const unsigned og = xb_add(&bar[XB_TOP], 1u);
            const unsigned tg = og / nx;
            if (og + 1u == (tg + 1u) * nx) xb_add(&bar[XB_TOPGEN], 1u);
            else XB_SPIN(xb_ld(&bar[XB_TOPGEN]) == tg, bar);
            __builtin_amdgcn_fence(__ATOMIC_ACQUIRE, "agent");
            xb_add(&bar[XB_XGEN(b.x)], 1u);
            asm volatile("s_waitcnt vmcnt(0)" ::: "memory");
        } else {
            XB_SPIN(xb_ld(&bar[XB_XGEN(b.x)]) == gen, bar);
            __builtin_amdgcn_fence(__ATOMIC_ACQUIRE, "agent");
            asm volatile("s_waitcnt vmcnt(0)" ::: "memory");
        }
    }
    __syncthreads();
}

template <int MODE> __device__ __forceinline__ int drow(int n) {
    if (MODE == 1) { const bool up = n >= FF; const int i = up ? n - FF : n; return (i >> 7) * 256 + (up ? 128 : 0) + (i & 127); }
    if (MODE == 2) { if (n >= 2560) return n; const int d = n & 127, a = d >> 6, w = d & 63, half = w >> 5, f = w & 31; return (n & ~127) + 2 * (a * 32 + f) + half; }
    return n;
}
template <int MODE> __device__ __forceinline__ void transpose_item(const float* W, int K, int N, bf16* WT, LAS float* scr, int item, int lane) {
    const int nblk = N / 64, kb = item / nblk, nb = item % nblk, k0 = 64 * kb, n0 = 64 * nb;
#pragma unroll
    for (int i = 0; i < 64; ++i) scr[i * 65 + lane] = W[(size_t)(k0 + i) * N + n0 + lane];
    LDS_WAIT(); asm volatile("" ::: "memory");
    const int c = lane & 7;
#pragma unroll
    for (int j = 0; j < 8; ++j) { const int n = (lane >> 3) + 8 * j; const LAS float* s = scr + (8 * c) * 65 + n;
        v4u o; o.x = pk2(s[0 * 65], s[1 * 65]); o.y = pk2(s[2 * 65], s[3 * 65]); o.z = pk2(s[4 * 65], s[5 * 65]); o.w = pk2(s[6 * 65], s[7 * 65]);
        *(GAS v4u*)(WT + (size_t)drow<MODE>(n0 + n) * K + k0 + 8 * c) = o; }
    LDS_WAIT(); asm volatile("" ::: "memory");
}
__device__ __forceinline__ void modulate_rows(const float* xl, const float* xc, int nrows, const float* ng, const float* shift, const float* scale, bf16* H, int gw, int NGW) {
    const int lane = lane_id();
    for (int row = gw; row < nrows; row += NGW) {
        const bool lat = row < ML; const int bp = lat ? (row >> 12) : 8;
        const float* src = lat ? xl + (size_t)row * DM : xc + (size_t)(row - ML) * DM;
        const GAS f32x4* xr = (const GAS f32x4*)src + lane;
        f32x4 v[8]; float s = 0.f;
#pragma unroll
        for (int j = 0; j < 8; ++j) { v[j] = xr[64 * j]; s += (v[j].x * v[j].x + v[j].y * v[j].y) + (v[j].z * v[j].z + v[j].w * v[j].w); }
        const float rstd = 1.0f / sqrtf(wave_sum(s) * (1.0f / DM) + EPS);
        const GAS f32x4* g4 = (const GAS f32x4*)ng + lane; const GAS f32x4* sh4 = (const GAS f32x4*)(shift + (size_t)bp * MODLD) + lane; const GAS f32x4* sc4 = (const GAS f32x4*)(scale + (size_t)bp * MODLD) + lane;
        GAS v2u* o8 = (GAS v2u*)(H + (size_t)row * DM) + lane;
#pragma unroll
        for (int j = 0; j < 8; ++j) { const f32x4 g = g4[64 * j], sh = sh4[64 * j], sc = sc4[64 * j];
            const f32x4 y = v[j] * rstd * g * (sc + 1.0f) + sh;
            v2u w; w.x = pk2(y.x, y.y); w.y = pk2(y.z, y.w); o8[64 * j] = w; }
    }
}

__device__ __forceinline__ void prep_rows(const float* xl, const float* xc, int nrows, const float* ng, const float* scale, bf16* XS, float* ss, int gw, int NGW) {
    const int lane = lane_id();
    f32x4 gg[8];
#pragma unroll
    for (int j = 0; j < 8; ++j) gg[j] = ((const GAS f32x4*)ng + lane)[64 * j];
    for (int row0 = 2 * gw; row0 < nrows; row0 += 2 * NGW) {
        const bool lat = row0 < ML;
        const GAS f32x4* xa = (const GAS f32x4*)(lat ? xl + (size_t)row0 * DM : xc + (size_t)(row0 - ML) * DM) + lane; const GAS f32x4* xb = xa + DM / 4;
        const GAS f32x4* sc4 = (const GAS f32x4*)(scale + (size_t)(lat ? (row0 >> 12) : 8) * MODLD) + lane;
        f32x4 va[8], vb[8], sc[8];
#pragma unroll
        for (int j = 0; j < 8; ++j) { va[j] = xa[64 * j]; vb[j] = xb[64 * j]; sc[j] = sc4[64 * j]; }
        GAS v2u* oa = (GAS v2u*)(XS + (size_t)row0 * DM) + lane; GAS v2u* ob = oa + DM / 4; float s0 = 0.f, s1 = 0.f;
#pragma unroll
        for (int j = 0; j < 8; ++j) { const f32x4 v = va[j], w = vb[j], m = gg[j] * (sc[j] + 1.0f);
            s0 += (v.x * v.x + v.y * v.y) + (v.z * v.z + v.w * v.w); s1 += (w.x * w.x + w.y * w.y) + (w.z * w.z + w.w * w.w);
            const f32x4 ya = v * m, yb = w * m;
            v2u pa, pb; pa.x = pk2(ya.x, ya.y); pa.y = pk2(ya.z, ya.w); pb.x = pk2(yb.x, yb.y); pb.y = pk2(yb.z, yb.w); oa[64 * j] = pa; ob[64 * j] = pb; }
        s0 = wave_sum(s0); s1 = wave_sum(s1); if (lane == 0) { ss[row0] = s0; ss[row0 + 1] = s1; }
    }
}
__device__ __forceinline__ void bias_gemv(const unsigned char* ws, const float* MOD, float* BIAS, int gw, int NGW) {
    typedef short bf16x8_t __attribute__((ext_vector_type(8)));
    const int lane = lane_id(), r16 = lane & 15, kq = lane >> 4;
    constexpr int B_IN = 2 * FF / 16, B_QKV = NQKV / 16, NITEM = 4 * B_IN + B_QKV, KQ = 4;
    asm volatile("" : "+v"(gw));
    for (int sub = gw; sub < NITEM * KQ; sub += NGW) {
        const int it = sub / KQ, q = sub % KQ;
        const int gi = it < 4 * B_IN ? it / B_IN : 4, n0 = (it - gi * B_IN) * 16;
        const bf16* W = gi < 4 ? (const bf16*)(ws + WS_WIN + (size_t)gi * WIN_BYTES) : (const bf16*)(ws + WS_WQKV);
        const int ldo = gi < 4 ? BIAS_IN_LD : NQKV; float* out = BIAS + (gi < 4 ? (size_t)gi * 9 * BIAS_IN_LD : (size_t)BIAS_QKV_OFF);
        const bf16* wp = W + (size_t)(n0 + r16) * DM + q * (DM / KQ) + kq * 8;
        const float* shift = MOD + (size_t)(gi < 4 ? (gi >> 1) : 1) * 9 * MODLD + (gi < 4 ? ((gi & 1) ? 6 : 0) : 3) * DM;
        const float* sp = shift + (size_t)(r16 < 9 ? r16 : 0) * MODLD + q * (DM / KQ) + kq * 8;
        f32x4 acc = (f32x4){0.f, 0.f, 0.f, 0.f};
#pragma unroll 8
        for (int ks = 0; ks < DM / 32 / KQ; ++ks) {
            const v4u wv = *(const GAS v4u*)(wp + ks * 32);
            f32x4 s0 = *(const GAS f32x4*)(sp + ks * 32), s1 = *(const GAS f32x4*)(sp + ks * 32 + 4);
            if (r16 >= 9) { s0 = (f32x4){0.f, 0.f, 0.f, 0.f}; s1 = s0; }
            v4u hi, lo;
            hi.x = pk2(s0.x, s0.y); hi.y = pk2(s0.z, s0.w); hi.z = pk2(s1.x, s1.y); hi.w = pk2(s1.z, s1.w);
            lo.x = pk2(s0.x - __uint_as_float(hi.x << 16), s0.y - __uint_as_float(hi.x & 0xffff0000u)); lo.y = pk2(s0.z - __uint_as_float(hi.y << 16), s0.w - __uint_as_float(hi.y & 0xffff0000u));
            lo.z = pk2(s1.x - __uint_as_float(hi.z << 16), s1.y - __uint_as_float(hi.z & 0xffff0000u)); lo.w = pk2(s1.z - __uint_as_float(hi.w << 16), s1.w - __uint_as_float(hi.w & 0xffff0000u));
            acc = __builtin_amdgcn_mfma_f32_16x16x32_bf16(__builtin_bit_cast(bf16x8_t, hi), __builtin_bit_cast(bf16x8_t, wv), acc, 0, 0, 0);
            acc = __builtin_amdgcn_mfma_f32_16x16x32_bf16(__builtin_bit_cast(bf16x8_t, lo), __builtin_bit_cast(bf16x8_t, wv), acc, 0, 0, 0);
        }
#pragma unroll
        for (int r = 0; r < 4; ++r) { const int bp = 4 * kq + r; if (bp < 9) (void)__hip_atomic_fetch_add(out + (size_t)bp * ldo + n0 + r16, acc[r], __ATOMIC_RELAXED, __HIP_MEMORY_SCOPE_AGENT); }
    }
}

__device__ __forceinline__ void phw_gemv(const float* PH, const bf16* WFOt, float* PHW, int wg, int nwg, int wave, LAS unsigned char* lds) {
    typedef short bf16x8_t __attribute__((ext_vector_type(8)));
    const int lane = lane_id(), r16 = lane & 15, kq = lane >> 4;
    LAS f32x4* part = (LAS f32x4*)lds;
    for (int it = wg; it < DM / 16; it += nwg) {
        const int n0 = it * 16;
        const bf16* wp = WFOt + (size_t)(n0 + r16) * DM + kq * 8 + wave * 256;
#pragma unroll
        for (int rb = 0; rb < 2; ++rb) {
            const int src0 = rb == 0 ? (r16 < 8 ? r16 : r16 + 8) : (r16 < 8 ? 24 + r16 : 24 + r16);
            const float* v0p = PH + (size_t)src0 * DM + kq * 8 + wave * 256; const float* v1p = PH + (size_t)(r16 & 7) * DM + kq * 8 + wave * 256;
            f32x4 acc = (f32x4){0.f, 0.f, 0.f, 0.f};
#pragma unroll
            for (int ks = 0; ks < 8; ++ks) {
                const v4u wv = *(const GAS v4u*)(wp + ks * 32);
                f32x4 s0 = *(const GAS f32x4*)(v0p + ks * 32), s1 = *(const GAS f32x4*)(v0p + ks * 32 + 4);
                if (rb == 0 && r16 >= 8) { s0 += *(const GAS f32x4*)(v1p + ks * 32); s1 += *(const GAS f32x4*)(v1p + ks * 32 + 4); }
                v4u hi, lo;
                hi.x = pk2(s0.x, s0.y); hi.y = pk2(s0.z, s0.w); hi.z = pk2(s1.x, s1.y); hi.w = pk2(s1.z, s1.w);
                lo.x = pk2(s0.x - __uint_as_float(hi.x << 16), s0.y - __uint_as_float(hi.x & 0xffff0000u)); lo.y = pk2(s0.z - __uint_as_float(hi.y << 16), s0.w - __uint_as_float(hi.y & 0xffff0000u));
                lo.z = pk2(s1.x - __uint_as_float(hi.z << 16), s1.y - __uint_as_float(hi.z & 0xffff0000u)); lo.w = pk2(s1.z - __uint_as_float(hi.w << 16), s1.w - __uint_as_float(hi.w & 0xffff0000u));
                acc = __builtin_amdgcn_mfma_f32_16x16x32_bf16(__builtin_bit_cast(bf16x8_t, hi), __builtin_bit_cast(bf16x8_t, wv), acc, 0, 0, 0);
                acc = __builtin_amdgcn_mfma_f32_16x16x32_bf16(__builtin_bit_cast(bf16x8_t, lo), __builtin_bit_cast(bf16x8_t, wv), acc, 0, 0, 0);
            }
            part[(rb * 8 + wave) * 64 + lane] = acc;
        }
        __syncthreads();
        if (wave < 2) { f32x4 t = part[(wave * 8) * 64 + lane];
#pragma unroll
            for (int w = 1; w < 8; ++w) t += part[(wave * 8 + w) * 64 + lane];
#pragma unroll
            for (int r = 0; r < 4; ++r) PHW[(size_t)(wave * 16 + 4 * kq + r) * DM + n0 + r16] = t[r] * (1.0f / 1024.0f); }
        __syncthreads();
    }
}

__device__ __forceinline__ void modrow(f32x4 (&y)[8], const float* row, const GAS f32x4* g4, const GAS f32x4* sh4, const GAS f32x4* sc4, int lane) {
    const GAS f32x4* xr = (const GAS f32x4*)row + lane; float s = 0.f;
#pragma unroll
    for (int q = 0; q < 8; ++q) { y[q] = xr[64 * q]; s += (y[q].x * y[q].x + y[q].y * y[q].y) + (y[q].z * y[q].z + y[q].w * y[q].w); }
    const float r = 1.0f / sqrtf(wave_sum(s) * (1.0f / DM) + EPS);
#pragma unroll
    for (int q = 0; q < 8; ++q) y[q] = y[q] * r * (g4[64 * q] * (sc4[64 * q] + 1.0f)) + sh4[64 * q];
}
__device__ __forceinline__ float ldrow(f32x4 (&y)[8], const float* row, int lane) {
    const GAS f32x4* xr = (const GAS f32x4*)row + lane; float s = 0.f;
#pragma unroll
    for (int q = 0; q < 8; ++q) y[q] = xr[64 * q];
#pragma unroll
    for (int q = 0; q < 8; ++q) s += (y[q].x * y[q].x + y[q].y * y[q].y) + (y[q].z * y[q].z + y[q].w * y[q].w);
    return s;
}
__device__ __forceinline__ void put_bf16_row(bf16* dst, const f32x4 (&y)[8], int lane) {
    GAS v2u* o = (GAS v2u*)dst + lane;
#pragma unroll
    for (int q = 0; q < 8; ++q) { v2u w; w.x = pk2(y[q].x, y[q].y); w.y = pk2(y[q].z, y[q].w); o[64 * q] = w; }
}
__device__ __forceinline__ void put_f32_row(float* dst, const f32x4 (&y)[8], int lane) {
    GAS f32x4* o = (GAS f32x4*)dst + lane;
#pragma unroll
    for (int q = 0; q < 8; ++q) o[64 * q] = y[q];
}
__device__ __forceinline__ void modulate_fold(const float* xl, const float* xc, const float* ng, const float* shift, const float* scale, bf16* H2, float* HM, float* HA, int gw, int NGW, LAS unsigned char* lds, int wave) {
    const int lane = lane_id();
    constexpr int M = SEQ / 2, NL = NB * (M / 2 + 1), NC = NB * (CTXL / 2 + 1);
    const int it0 = (int)(((long)gw * (NL + NC)) / NGW), it1 = (int)(((long)(gw + 1) * (NL + NC)) / NGW);
    LAS f32x4* hacc = (LAS f32x4*)lds + (size_t)(wave * 64 + lane) * 8;
    int hb = -1;
#pragma unroll
    for (int q = 0; q < 8; ++q) hacc[q] = (f32x4){0.f, 0.f, 0.f, 0.f};
#define HA_FLUSH() do { if (hb >= 0) { float* hp = HA + (size_t)hb * DM + lane * 4; _Pragma("unroll") for (int q = 0; q < 8; ++q) { const f32x4 hv = hacc[q]; unsafeAtomicAdd(hp + 256 * q + 0, hv.x); unsafeAtomicAdd(hp + 256 * q + 1, hv.y); unsafeAtomicAdd(hp + 256 * q + 2, hv.z); unsafeAtomicAdd(hp + 256 * q + 3, hv.w); hacc[q] = (f32x4){0.f, 0.f, 0.f, 0.f}; } } } while (0)
    for (int it = it0; it < it1; ++it) {
        int lane_ = lane; asm volatile("" : "+v"(lane_));
        const GAS f32x4* g4 = (const GAS f32x4*)ng + lane_;
        if (it < NL) {
            const int b = it / (M / 2 + 1), n = it - b * (M / 2 + 1);
            if (b != hb) { HA_FLUSH(); hb = b; }
            const float* base = xl + (size_t)b * SEQ * DM;
            const GAS f32x4* sh4 = (const GAS f32x4*)(shift + (size_t)b * MODLD) + lane_; const GAS f32x4* sc4 = (const GAS f32x4*)(scale + (size_t)b * MODLD) + lane_;
            bf16* p0 = H2 + ((size_t)(b * 4 + 0) * 1024 + n) * DM; const size_t pstep = (size_t)1024 * DM;
            f32x4 ya[8], yb[8];
            if (n == 0) {
                modrow(ya, base, g4, sh4, sc4, lane_); modrow(yb, base + (size_t)M * DM, g4, sh4, sc4, lane_);
                put_f32_row(HM + (size_t)b * DM, yb, lane_);
#pragma unroll
                for (int q = 0; q < 8; ++q) hacc[q] += ya[q];
                put_bf16_row(p0, ya, lane_); put_bf16_row(p0 + pstep, ya, lane_);
#pragma unroll
                for (int q = 0; q < 8; ++q) ya[q] = (f32x4){0.f, 0.f, 0.f, 0.f};
                put_bf16_row(p0 + 2 * pstep, ya, lane_); put_bf16_row(p0 + 3 * pstep, ya, lane_);
            } else if (n == M / 2) {
                modrow(ya, base + (size_t)(M / 2) * DM, g4, sh4, sc4, lane_); modrow(yb, base + (size_t)(M + M / 2) * DM, g4, sh4, sc4, lane_);
                f32x4 e[8], o[8];
#pragma unroll
                for (int q = 0; q < 8; ++q) { e[q] = ya[q] + yb[q]; o[q] = ya[q] - yb[q]; hacc[q] += e[q]; }
                put_f32_row(HM + (size_t)(16 + b) * DM, e, lane_); put_f32_row(HM + (size_t)(24 + b) * DM, o, lane_);
            } else {
                f32x4 yc[8], yd[8], gmv[8], shv[8];
#pragma unroll
                for (int q = 0; q < 8; ++q) { gmv[q] = g4[64 * q] * (sc4[64 * q] + 1.0f); shv[q] = sh4[64 * q]; }
                float sa = ldrow(ya, base + (size_t)n * DM, lane_), sb = ldrow(yb, base + (size_t)(SEQ - n) * DM, lane_), sc = ldrow(yc, base + (size_t)(M - n) * DM, lane_), sd = ldrow(yd, base + (size_t)(M + n) * DM, lane_);
#pragma unroll
                for (int o = 1; o < 64; o <<= 1) { sa += __shfl_xor(sa, o); sb += __shfl_xor(sb, o); sc += __shfl_xor(sc, o); sd += __shfl_xor(sd, o); }
                const float ra = 1.0f / sqrtf(sa * (1.0f / DM) + EPS), rb = 1.0f / sqrtf(sb * (1.0f / DM) + EPS), rc = 1.0f / sqrtf(sc * (1.0f / DM) + EPS), rd = 1.0f / sqrtf(sd * (1.0f / DM) + EPS);
                const float sgn = (n & 1) ? -1.0f : 1.0f;
#pragma unroll
                for (int q = 0; q < 8; ++q) { const f32x4 gm = gmv[q], sh = shv[q];
                    const f32x4 a = ya[q] * ra, b2 = yb[q] * rb, c2 = yc[q] * rc, d2 = yd[q] * rd;
                    const f32x4 hen = (a + b2) * gm + sh * 2.0f, hem = (c2 + d2) * gm + sh * 2.0f, hon = (a - b2) * gm, hom = (c2 - d2) * gm;
                    ya[q] = hen + hem; yb[q] = hen - hem; yc[q] = hon - hom; yd[q] = hon + hom; hacc[q] += ya[q] * sgn; }
                put_bf16_row(p0, ya, lane_); put_bf16_row(p0 + pstep, yb, lane_); put_bf16_row(p0 + 2 * pstep, yc, lane_); put_bf16_row(p0 + 3 * pstep, yd, lane_);
            }
        } else {
            const int j = it - NL, b = j / (CTXL / 2 + 1), n = j - b * (CTXL / 2 + 1);
            const float* base = xc + (size_t)b * CTXL * DM;
            const GAS f32x4* sh4 = (const GAS f32x4*)(shift + (size_t)8 * MODLD) + lane_; const GAS f32x4* sc4 = (const GAS f32x4*)(scale + (size_t)8 * MODLD) + lane_;
            f32x4 ya[8], yb[8];
            if (n == CTXL / 2) { modrow(ya, base + (size_t)n * DM, g4, sh4, sc4, lane_); put_f32_row(HM + (size_t)(8 + b) * DM, ya, lane_); }
            else { modrow(ya, base + (size_t)n * DM, g4, sh4, sc4, lane_);
                if (n == 0) {
#pragma unroll
                    for (int q = 0; q < 8; ++q) yb[q] = (f32x4){0.f, 0.f, 0.f, 0.f}; }
                else { modrow(yb, base + (size_t)(CTXL - n) * DM, g4, sh4, sc4, lane_);
#pragma unroll
                    for (int q = 0; q < 8; ++q) { const f32x4 e = ya[q] + yb[q], o = ya[q] - yb[q]; ya[q] = e; yb[q] = o; } }
                put_bf16_row(H2 + ((size_t)ML + 0 * 1024 + b * 128 + n) * DM, ya, lane_); put_bf16_row(H2 + ((size_t)ML + 1 * 1024 + b * 128 + n) * DM, yb, lane_); }
        }
    }
    HA_FLUSH();
#undef HA_FLUSH
}

struct Ctx { LAS unsigned char* lds; char* lds_gen; unsigned char* ws; int G, bx, vcu, gw, NGW, wave, lo, hi;
    const float* x_in; const float* ctx_in; const float* norm_g; float* X; float* XC; const float* MOD; const float* TABC; const float* TABS; const float* GQ; const float* GK; };
#define IN() (c.lo <= ph && ph < c.hi)
#ifdef PROBE_PHASE
#define SEAM() do { if (c.lo <= ph && ph + 1 < c.hi) xcd_barrier(bar); if (blockIdx.x == 0 && c.wave == 0 && lane_id() == 0) ((volatile LAS unsigned*)(c.lds + MISC_OFF))[17 + ph] = (unsigned)__builtin_amdgcn_s_memrealtime(); ++ph; } while (0)
#else
#define SEAM() do { if (c.lo <= ph && ph + 1 < c.hi) xcd_barrier(bar); ++ph; } while (0)
#endif
template <int f> __device__ __forceinline__ void macaron_step(const Ctx& c, const XcdBarrier& bar, int& ph) {
    LAS unsigned char* lds = c.lds; unsigned char* ws = c.ws; const int G = c.G, bx = c.bx, vcu = c.vcu, gw = c.gw, NGW = c.NGW;
    const float* x_in = c.x_in; const float* ctx_in = c.ctx_in; const float* norm_g = c.norm_g; float* X = c.X; float* XC = c.XC; const float* MOD = c.MOD;
    const float* TABC = c.TABC; const float* TABS = c.TABS; const float* GQ = c.GQ; const float* GK = c.GK;
    bf16* WCH = (bf16*)(ws + WS_WC); bf16* SEQC = WCH + 512 * 256; bf16* SEQM = (bf16*)(ws + WS_SEQ);
    bf16* WFO = (bf16*)(ws + WS_WFO); bf16* WQKV = (bf16*)(ws + WS_WQKV); bf16* WAO = (bf16*)(ws + WS_WAO);
    bf16* H = (bf16*)(ws + WS_H); bf16* HID = (bf16*)(ws + WS_HID); bf16* PQT = (bf16*)(ws + WS_PQT); bf16* PQTC = (bf16*)(ws + WS_PQTC);
    bf16* FB = (bf16*)(ws + WS_F); bf16* QB = (bf16*)(ws + WS_Q); bf16* KB = (bf16*)(ws + WS_K); bf16* VB = (bf16*)(ws + WS_V); bf16* OB = (bf16*)(ws + WS_O);
    float* SLAB = (float*)(ws + WS_O); unsigned* ctl = (unsigned*)(ws + WS_CTL); (void)SLAB; (void)ctl;
    float* HM = (float*)(ws + WS_TAB + TAB_HM); float* PH = (float*)(ws + WS_TAB + TAB_PH); (void)HM; (void)PH;
    (void)vcu; (void)WCH; (void)SEQC; (void)SEQM; (void)WFO; (void)WQKV; (void)WAO; (void)PQT; (void)PQTC; (void)FB; (void)QB; (void)KB; (void)VB; (void)OB; (void)TABC; (void)TABS; (void)GQ; (void)GK; (void)x_in; (void)ctx_in;
    const int ly = f >> 1, sub = f & 1;
    const float* modl = MOD + (size_t)ly * 9 * MODLD;
    const float* xs_l = (f == 0) ? x_in : X; const float* xs_c = (f == 0) ? ctx_in : XC;
    const int nMf = (f == 3) ? ML / 256 : MA / 256;
    float* SSB = (float*)(ws + WS_CTL) + CW_SS; float* BIAS = (float*)(ws + WS_BIAS);
    float* STG = (float*)(ws + (f == 0 ? WS_Q : WS_F)) + (size_t)bx * 65536; const bool stag_on = false;
    if constexpr (f == 0) {
        if (IN()) { bias_gemv(ws, MOD, BIAS, gw, NGW); prep_rows(x_in, ctx_in, MA, norm_g, modl + 1 * DM, H, SSB, gw, NGW); }
        SEAM();
    }
    if (IN()) {
        pg8::MapPlain mp{(const char*)H, (const char*)(ws + WS_WIN + (size_t)f * WIN_BYTES), 256u * DM * 2, 256u * DM * 2, DM / 64, 0, 0};
        pg8::GridOrder<pg8::MapPlain> S; S.init(nMf, 2 * FF / 256, G, bx, mp);
        pg8::EpiSwiGLU E{HID, SSB + (size_t)(f == 3 ? 4 : f) * MA, BIAS + (size_t)f * 9 * BIAS_IN_LD};
        pg8::gemm_phase<pg8::EpiSwiGLU, pg8::GridOrder<pg8::MapPlain>, true, true>(lds, DM, DM, S, E, c.wave);
    }
    SEAM();
    if (IN()) {
        const char* wout = (const char*)(ws + WS_WOUT + (size_t)f * WOUT_BYTES);
        pg8::MapPlain mp{(const char*)HID, wout, 256u * FF * 2, 256u * FF * 2, FF / 64, 0, 0};
        pg8::ResidOrder S; S.lat.init(ML / 256, DM / 256, G, bx, mp); S.lat.wgm = 4; S.n_ctx = (f == 3) ? 0 : 256; S.Ac = (const char*)(HID + (size_t)ML * FF);
        S.ksplit = (unsigned)(FF / 4) * 2; S.nt_split = FF / 4 / 64;
        constexpr bool NX = (f == 1 || f == 2);
        pg8::EpiResid<true, NX> E{xs_l, xs_c, X, ws, ly * 9 * MODLD + (sub ? 8 : 2) * DM, CW_TICK + f * 64 * 64,
                                  norm_g + (size_t)(3 + (f == 2 ? 1 : 0)) * DM, 9 * MODLD + (f == 2 ? 4 : 1) * DM, CW_SS + (f == 2 ? 3 : 2) * MA};
        pg8::gemm_phase<pg8::EpiResid<true, NX>, pg8::ResidOrder, true, true>(lds, FF, FF, S, E, c.wave);
        pg8::finish_split_units(S, E, c.wave);
    }
    SEAM();
    if constexpr (f == 0) {
        if (IN()) modulate_fold(X, XC, norm_g + (size_t)(ly * 3 + 1) * DM, modl + 3 * DM, modl + 4 * DM, H, HM, (float*)(ws + WS_CTL) + CW_HA, gw, NGW, lds, c.wave);
        SEAM();
        if (IN()) {
            {
                const int gid = bx * 512 + c.wave * 64 + lane_id();
                if (gid < 40 * DM) { const int bb = gid >> 11, l = gid & 2047;
                    const float* src = bb < 16 ? HM + (size_t)bb * DM : (bb < 24 ? (const float*)(ws + WS_CTL) + CW_HA + (size_t)(bb - 16) * DM : HM + (size_t)(bb - 8) * DM);
                    const float* hm = src + (l & ~255); const bf16* wrow = WCH + (size_t)((bb >= 32 ? 256 : 0) + (l & 255)) * 256; float a = 0.f;
#pragma unroll 8
                    for (int c8 = 0; c8 < 256; c8 += 8) { const v4u w = *(const GAS v4u*)(wrow + c8); const f32x4 h0 = *(const GAS f32x4*)(hm + c8), h1 = *(const GAS f32x4*)(hm + c8 + 4);
                        a += h0.x * __uint_as_float(w.x << 16) + h0.y * __uint_as_float(w.x & 0xffff0000u) + h0.z * __uint_as_float(w.y << 16) + h0.w * __uint_as_float(w.y & 0xffff0000u)
                           + h1.x * __uint_as_float(w.z << 16) + h1.y * __uint_as_float(w.z & 0xffff0000u) + h1.z * __uint_as_float(w.w << 16) + h1.w * __uint_as_float(w.w & 0xffff0000u); }
                    PH[gid] = a; }
            }
            pg8::F1Order S; S.G = G; S.c = bx; S.Wc = (const char*)WCH; S.H = (const char*)H;
            pg8::EpiF1 E{PQT, PQTC};
            pg8::gemm_phase<pg8::EpiF1, pg8::F1Order, true, true>(lds, 256, DM, S, E, c.wave);
        }
        SEAM();
        if (IN()) {
            phw_gemv(PH, WFO, (float*)(ws + WS_TAB + TAB_PHW), (bx + G / 2) % G, G, c.wave, lds);
            {
                pg8::MapUV mp{(const char*)SEQM, (const char*)PQT};
                pg8::GridOrder<pg8::MapUV> S; S.init(ML / 256, DM / 256, G, bx, mp);
                pg8::EpiUV E{FB};
                pg8::gemm_phase<pg8::EpiUV, pg8::GridOrder<pg8::MapUV>, true, true>(lds, 1024, 4096, S, E, c.wave);
            }
            {
                pg8::MapF2 mp{(const char*)SEQC, (const char*)PQTC, (size_t)0, (size_t)DM * 256 * 2, (size_t)256 * 256 * 2, 0, 256 / 64, ML / 256};
                pg8::GridOrder<pg8::MapF2> S; S.init(NB, DM / 256, G, bx, mp);
                pg8::EpiF2 E{FB, PH, 1.0f / 256.0f};
                pg8::gemm_phase<pg8::EpiF2, pg8::GridOrder<pg8::MapF2>, true, true>(lds, 256, 256, S, E, c.wave);
            }
        }
        SEAM();
        if (IN()) {
            pg8::MapPlain mp{(const char*)FB, (const char*)WFO, 256u * DM * 2, 256u * DM * 2, DM / 64, 0, 0};
            pg8::ResidOrder S; S.lat.init(ML / 256, DM / 256, G, bx, mp); S.lat.wgm = 4; S.n_ctx = 256; S.Ac = (const char*)(FB + (size_t)ML * DM);
            S.ksplit = (unsigned)(DM / 4) * 2; S.nt_split = DM / 4 / 64;
            pg8::EpiResid<false, true, true> E{X, XC, X, ws, 5 * DM, CW_TICK + 3 * 64 * 64, norm_g + (size_t)2 * DM, 7 * DM, CW_SS + 1 * MA};
            pg8::gemm_phase<pg8::EpiResid<false, true, true>, pg8::ResidOrder, true, true>(lds, DM, DM, S, E, c.wave);
            pg8::finish_split_units(S, E, c.wave);
        }
        SEAM();
    }
    if constexpr (f == 2) {
        if (IN()) {
            pg8::EpiQKV E{QB, KB, VB, TABC, TABS, GQ, GK, SSB + (size_t)3 * MA, BIAS + BIAS_QKV_OFF};
            for (int part = 0; part < 2; ++part) {
                pg8::MapPlain mp = part == 0 ? pg8::MapPlain{(const char*)H, (const char*)WQKV, 256u * DM * 2, 256u * DM * 2, DM / 64, 0, 0}
                                             : pg8::MapPlain{(const char*)(H + (size_t)ML * DM), (const char*)(WQKV + (size_t)2048 * DM), 256u * DM * 2, 256u * DM * 2, DM / 64, ML / 256, 8};
                pg8::GridOrder<pg8::MapPlain> S; S.init(part == 0 ? ML / 256 : MC / 256, part == 0 ? 12 : 4, G, bx, mp);
                pg8::gemm_phase<pg8::EpiQKV, pg8::GridOrder<pg8::MapPlain>, true, true>(lds, DM, DM, S, E, c.wave);
            }
        }
        SEAM();
        if (IN()) {
            for (int L = vcu; L < NB * NH * (SEQ / 256); L += G) {
                const int pair = L >> 6, wi = L & 63, b = pair >> 2, kvh = pair & 3, h = kvh * 4 + (wi >> 4), qb = wi & 15;
                att::attn_dense_body(QB + ((size_t)(b * SEQ + qb * 256)) * DM + h * HD, KB + (size_t)(b * NKV + kvh) * SKV * HD, VB + (size_t)(b * NKV + kvh) * SKV * HD,
                                     OB + ((size_t)(b * SEQ + qb * 256)) * DM + h * HD, SKV, c.lds_gen, c.wave);
            }
        }
        SEAM();
        if (IN()) {
            pg8::MapPlain mp{(const char*)OB, (const char*)WAO, 256u * DM * 2, 256u * DM * 2, DM / 64, 0, 0};
            pg8::GridOrder<pg8::MapPlain> S; S.init(ML / 256, DM / 256, G, bx, mp); S.wgm = 4;
            pg8::EpiResid<false, true> E{X, XC, X, ws, 9 * MODLD + 5 * DM, 0, norm_g + (size_t)5 * DM, 9 * MODLD + 7 * DM, CW_SS + 4 * MA};
            pg8::gemm_phase<pg8::EpiResid<false, true>, pg8::GridOrder<pg8::MapPlain>, true, true>(lds, DM, DM, S, E, c.wave);
        }
        SEAM();
    }
}
#undef IN
#undef SEAM

struct Args { const float* in[14]; float* out; unsigned char* ws; int ph_lo, ph_hi; };
constexpr int N_PHASES = 17;

__global__ void __launch_bounds__(512, 2) fwd(Args args) {
    extern __shared__ __attribute__((aligned(16))) unsigned char lds_raw[];
    LAS unsigned char* lds = (LAS unsigned char*)lds_raw;
    volatile LAS unsigned* MISC = (volatile LAS unsigned*)(lds + MISC_OFF);
    const int tid = threadIdx.x, lane = tid & 63, wave = __builtin_amdgcn_readfirstlane(tid >> 6);
    const int G = gridDim.x, bx = blockIdx.x;
    const int vcu = (G % 8 == 0) ? (bx % 8) * (G / 8) + bx / 8 : bx;
    unsigned char* ws = args.ws;
    unsigned* ctl = (unsigned*)(ws + WS_CTL);
    const float* x_in = args.in[0]; const float* ctx_in = args.in[2]; const float* norm_g = args.in[6];
#define KARG(i) ([&]() { const __attribute__((address_space(4))) Args* ap_ = (const __attribute__((address_space(4))) Args*)__builtin_amdgcn_kernarg_segment_ptr(); asm volatile("" : "+s"(ap_)); return ap_->in[i]; }())
    float* X = args.out; float* XC = (float*)(ws + WS_XC);
    float* MOD = (float*)(ws + WS_MOD);
    float* TABC = (float*)(ws + WS_TAB); float* TABS = TABC + 2048; float* GQ = TABS + 2048; float* GK = GQ + 128;
    bf16* WCH = (bf16*)(ws + WS_WC); bf16* SEQC = WCH + 512 * 256; bf16* SEQM = (bf16*)(ws + WS_SEQ);
    bf16* WFO = (bf16*)(ws + WS_WFO); bf16* WQKV = (bf16*)(ws + WS_WQKV); bf16* WAO = (bf16*)(ws + WS_WAO);
    bf16* H = (bf16*)(ws + WS_H); bf16* HID = (bf16*)(ws + WS_HID); bf16* PQT = (bf16*)(ws + WS_PQT); bf16* PQTC = (bf16*)(ws + WS_PQTC);
    bf16* FB = (bf16*)(ws + WS_F); bf16* QB = (bf16*)(ws + WS_Q); bf16* KB = (bf16*)(ws + WS_K); bf16* VB = (bf16*)(ws + WS_V); bf16* OB = (bf16*)(ws + WS_O);

    for (int u = tid; u < (LDS_BYTES - RING_BYTES) / 4; u += 512) ((LAS unsigned*)(lds + RING_BYTES))[u] = 0u;
    __syncthreads();
    const int lo = args.ph_lo, hi = args.ph_hi;
    XcdBarrier bar; bar.bar = ctl + CW_BAR; bar.x = 0; bar.st = MISC + 8; bar.wave = wave;
    if (hi - lo > 1) bar = xcd_barrier_post(ctl + CW_BAR, MISC + 8, wave);
    int ph = 0;
#define IN() (lo <= ph && ph < hi)
#ifdef PROBE_PHASE
    if (bx == 0 && tid == 0) MISC[16] = (unsigned)__builtin_amdgcn_s_memrealtime();
#define SEAM() do { if (lo <= ph && ph + 1 < hi) xcd_barrier(bar); if (bx == 0 && tid == 0) MISC[17 + ph] = (unsigned)__builtin_amdgcn_s_memrealtime(); ++ph; } while (0)
#else
#define SEAM() do { if (lo <= ph && ph + 1 < hi) xcd_barrier(bar); ++ph; } while (0)
#endif
    const int gw = vcu * 8 + wave, NGW = G * 8;

    if (IN()) {
        LAS float* lut = (LAS float*)lds;
        for (int j = tid; j < 4096; j += 512) lut[j] = cospif((float)j * (1.0f / 2048.0f));
        __syncthreads();
        {
            const int nchunk = 4 * 1024 * 128;
            for (int ch = bx * 512 + tid; ch < nchunk; ch += G * 512) { const int kind = ch >> 17, j = (ch >> 7) & 1023, n8 = (ch & 127) * 8, kk = 2 * j + (kind & 1), ph0 = (kind & 2) ? 3072 : 0; unsigned w[4];
#pragma unroll
                for (int e = 0; e < 4; ++e) { const int n0 = n8 + 2 * e, n1 = n0 + 1; w[e] = pk2(lut[(kk * n0 + ph0) & 4095], lut[(kk * n1 + ph0) & 4095]); }
                *(GAS v4u*)(SEQM + (size_t)ch * 8) = (v4u){w[0], w[1], w[2], w[3]}; }
            for (int e = bx * 512 + tid; e < 256 * 256; e += G * 512) { const int k = e >> 8, n = e & 255;
                SEQC[e] = (bf16)f2bf(lut[n < 128 ? (k * n * 16) & 4095 : (k * (n - 128) * 16 + 1024) & 4095]); }
            for (int e = bx * 512 + tid; e < 512 * 256; e += G * 512) { const int l = e >> 8, c = e & 255;
                WCH[e] = (bf16)f2bf(lut[l < 256 ? (l * c * 16) & 4095 : ((l - 256) * c * 16 + 3072) & 4095]); }
        }
        for (int i = bx * 512 + tid; i < (4 * 9 * BIAS_IN_LD + 9 * NQKV) / 4; i += G * 512) ((GAS f32x4*)(ws + WS_BIAS))[i] = (f32x4){0.f, 0.f, 0.f, 0.f};
        if (bx == 0) {
            for (int t = tid; t < 2048; t += 512) { const int pos = t >> 5, f = t & 31; const double inv = pow(10000.0, -(double)f / 32.0), ang = (double)pos * inv;
                TABC[t] = (float)cos(ang); TABS[t] = (float)sin(ang); }
            if (tid < 128) { const int i = tid >> 1, hf = tid & 1, d = (i < 32 ? i : i + 32) + 32 * hf; const float* qng = KARG(11); const float* kng = KARG(12); GQ[tid] = qng[d]; GK[tid] = kng[d]; }
        }
        __syncthreads();
        {
            LAS float* s_sh = (LAS float*)lds;
            LAS float* red = (LAS float*)(lds + 81920);
            const float* c_in = KARG(1); const float* cctx_in = KARG(3); const float* w_ada = KARG(4); const float* b_ada = KARG(5);
            for (int i = tid; i < 9 * DM; i += 512) { const int bp = i >> 11, k = i & 2047; const float cv = bp < 8 ? c_in[bp * DM + k] : cctx_in[k]; s_sh[i] = cv / (1.0f + expf(-cv)); }
            __syncthreads();
            const int cg = lane & 7, ksl = wave * 8 + (lane >> 3), k0 = ksl * 32;
            for (int it = bx; it < 2 * 576; it += G) {
                const int ly = it / 576, j0 = (it % 576) * 32;
                const float* wp = w_ada + (size_t)ly * DM * MODLD + (size_t)k0 * MODLD + j0 + 4 * cg;
                f32x4 a[9];
#pragma unroll
                for (int b = 0; b < 9; ++b) a[b] = (f32x4){0.f, 0.f, 0.f, 0.f};
                for (int kk = 0; kk < 32; kk += 4) {
                    const f32x4 w0 = *(const GAS f32x4*)(wp + (size_t)(kk + 0) * MODLD), w1 = *(const GAS f32x4*)(wp + (size_t)(kk + 1) * MODLD);
                    const f32x4 w2 = *(const GAS f32x4*)(wp + (size_t)(kk + 2) * MODLD), w3 = *(const GAS f32x4*)(wp + (size_t)(kk + 3) * MODLD);
#pragma unroll
                    for (int b = 0; b < 9; ++b) { const f32x4 s4 = *(const LAS f32x4*)(s_sh + b * DM + k0 + kk); a[b] += w0 * s4.x + w1 * s4.y + w2 * s4.z + w3 * s4.w; }
                }
#pragma unroll
                for (int b = 0; b < 9; ++b)
#pragma unroll
                    for (int e = 0; e < 4; ++e) { float v = a[b][e]; v += __shfl_xor(v, 8); v += __shfl_xor(v, 16); v += __shfl_xor(v, 32); a[b][e] = v; }
                if (lane < 8) {
#pragma unroll
                    for (int b = 0; b < 9; ++b) *(LAS f32x4*)(red + (wave * 8 + cg) * 36 + b * 4) = a[b]; }
                __syncthreads();
                if (tid < 288) { const int bp = tid >> 5, jj = tid & 31; float v = b_ada[(size_t)ly * MODLD + j0 + jj];
#pragma unroll
                    for (int w = 0; w < 8; ++w) v += red[(w * 8 + (jj >> 2)) * 36 + bp * 4 + (jj & 3)];
                    MOD[((size_t)ly * 9 + bp) * MODLD + j0 + jj] = v; }
                __syncthreads();
            }
        }
        {
            LAS float* scr = (LAS float*)(lds + wave * 17408);
            constexpr int I_IN = (DM / 64) * (2 * FF / 64), I_OUT = (FF / 64) * (DM / 64), I_SQ = (DM / 64) * (DM / 64), I_QKV = (DM / 64) * (NQKV / 64);
            static_assert(8 * 17408 <= MISC_OFF && 64 * 65 * 4 <= 17408, "transpose scratch");
            constexpr int NITEMS = 4 * I_IN + 4 * I_OUT + 2 * I_SQ + I_QKV;
            const float* w_ffn_in = KARG(7); const float* w_ffn_out = KARG(8); const float* w_fo = KARG(9); const float* w_qkv = KARG(10); const float* w_ao = KARG(13);
            for (int it = gw; it < NITEMS; it += NGW) {
                int r = NITEMS - 1 - it;
                if (r < 4 * I_IN) { const int f = r / I_IN; transpose_item<1>(w_ffn_in + (size_t)f * DM * 2 * FF, DM, 2 * FF, (bf16*)(ws + WS_WIN + (size_t)f * WIN_BYTES), scr, r % I_IN, lane); continue; } r -= 4 * I_IN;
                if (r < 4 * I_OUT) { const int f = r / I_OUT; transpose_item<0>(w_ffn_out + (size_t)f * FF * DM, FF, DM, (bf16*)(ws + WS_WOUT + (size_t)f * WOUT_BYTES), scr, r % I_OUT, lane); continue; } r -= 4 * I_OUT;
                if (r < I_SQ) { transpose_item<0>(w_fo, DM, DM, WFO, scr, r, lane); continue; } r -= I_SQ;
                if (r < I_SQ) { transpose_item<0>(w_ao, DM, DM, WAO, scr, r, lane); continue; } r -= I_SQ;
                transpose_item<2>(w_qkv, DM, NQKV, WQKV, scr, r, lane);
            }
        }
    }
    SEAM();

    {
        Ctx c; c.lds = lds; c.lds_gen = (char*)lds_raw; c.ws = ws; c.G = G; c.bx = bx; c.vcu = vcu; c.gw = gw; c.NGW = NGW; c.wave = wave; c.lo = lo; c.hi = hi;
        c.x_in = x_in; c.ctx_in = ctx_in; c.norm_g = norm_g; c.X = X; c.XC = XC; c.MOD = MOD; c.TABC = TABC; c.TABS = TABS; c.GQ = GQ; c.GK = GK;
        macaron_step<0>(c, bar, ph); macaron_step<1>(c, bar, ph); macaron_step<2>(c, bar, ph); macaron_step<3>(c, bar, ph);
    }
#ifdef PROBE_PHASE
    if (bx == 0 && tid == 0) { const unsigned d = MISC[17 + PROBE_PHASE] - MISC[16 + PROBE_PHASE]; const unsigned long long t0 = __builtin_amdgcn_s_memrealtime(); while (__builtin_amdgcn_s_memrealtime() - t0 < (unsigned long long)d * PROBE_AMP) __builtin_amdgcn_s_sleep(8); }
#endif
#undef IN
#undef SEAM
}

extern "C" void kernel_launch(void* const* d_in, const int* in_sizes, int n_in, void* d_out, int out_size, void* d_ws, size_t ws_size, hipStream_t stream) {
    static int grid = 0;
    if (grid == 0) {
        if (n_in != 14 || in_sizes[0] != ML * DM || out_size != ML * DM || ws_size < WS_END) { fprintf(stderr, "kernel_launch: shape/workspace mismatch (n_in %d, in0 %d, out %d, ws %zu, need %zu)\n", n_in, n_in > 0 ? in_sizes[0] : -1, out_size, ws_size, (size_t)WS_END); grid = -1; return; }
        int dev = 0, cus = 0, per_cu = 0;
        if (hipGetDevice(&dev) != hipSuccess || hipDeviceGetAttribute(&cus, hipDeviceAttributeMultiprocessorCount, dev) != hipSuccess) { grid = -1; return; }
        if (hipFuncSetAttribute((const void*)fwd, hipFuncAttributeMaxDynamicSharedMemorySize, LDS_BYTES) != hipSuccess) { fprintf(stderr, "kernel_launch: hipFuncSetAttribute failed\n"); grid = -1; return; }
        if (hipOccupancyMaxActiveBlocksPerMultiprocessor(&per_cu, (const void*)fwd, 512, LDS_BYTES) != hipSuccess || per_cu < 1) fprintf(stderr, "kernel_launch: occupancy query says %d\n", per_cu);
        (void)hipGetLastError();
        grid = cus;
    }
    if (grid < 0) return;
    (void)hipMemsetAsync((char*)d_ws + WS_CTL, 0, CTL_ZERO_BYTES, stream);
    Args a{};
    for (int i = 0; i < 14; ++i) a.in[i] = (const float*)d_in[i];
    a.out = (float*)d_out; a.ws = (unsigned char*)d_ws;
#if MK_ONE_LAUNCH
    a.ph_lo = 0; a.ph_hi = N_PHASES;
    hipLaunchKernelGGL(fwd, dim3(grid), dim3(512), LDS_BYTES, stream, a);
#else
    for (int p = 0; p < N_PHASES; ++p) { a.ph_lo = p; a.ph_hi = p + 1; hipLaunchKernelGGL(fwd, dim3(grid), dim3(512), LDS_BYTES, stream, a); }
#endif
    const hipError_t le = hipPeekAtLastError();
    if (le != hipSuccess) fprintf(stderr, "kernel_launch: launch failed: %s\n", hipGetErrorName(le));
}
```

```cpp
#include <hip/hip_runtime.h>
#include <cstdio>
#include <cstdint>

#ifndef PROBE_AMP
#define PROBE_AMP 8
#endif
#ifndef MK_ONE_LAUNCH
#define MK_ONE_LAUNCH 1
#endif

#define GAS __attribute__((address_space(1)))
#define LAS __attribute__((address_space(3)))
#define PG8_LAS __attribute__((address_space(3)))

constexpr int NB = 8, SEQ = 4096, DM = 2048, CTXL = 256, FF = 5632, NMOD = 9;
constexpr int ML = NB * SEQ, MC = NB * CTXL, MA = ML + MC;
constexpr int NQKV = 3072, HD = 128, NH = 16, NKV = 4, SKV = SEQ + CTXL;
constexpr int MODLD = NMOD * DM;
constexpr float EPS = 1e-6f;

constexpr size_t MiB = 1u << 20;
constexpr size_t WS_CTL = 0, CTL_ZERO_BYTES = 1 * MiB;
constexpr size_t WS_MOD = 1 * MiB;
constexpr size_t WS_TAB = 3 * MiB;
constexpr size_t WS_WC = 4 * MiB;
constexpr size_t WS_SEQ = 5 * MiB;
constexpr size_t WS_WIN = 69 * MiB;
constexpr size_t WS_WOUT = 245 * MiB;
constexpr size_t WS_WFO = 333 * MiB, WS_WQKV = 341 * MiB, WS_WAO = 353 * MiB;
constexpr size_t WS_XC = 361 * MiB;
constexpr size_t WS_H = 377 * MiB;
constexpr size_t WS_HID = 513 * MiB;
constexpr size_t WS_PQT = WS_HID, WS_PQTC = WS_HID + 256 * MiB;
constexpr size_t WS_F = 887 * MiB;
constexpr size_t WS_Q = 1023 * MiB;
constexpr size_t WS_K = 1151 * MiB, WS_V = 1185 * MiB;
constexpr size_t WS_O = 1219 * MiB;
constexpr size_t WS_BIAS = 1347 * MiB;
constexpr size_t WS_END = 1349 * MiB;
constexpr size_t WIN_BYTES = (size_t)2 * FF * DM * 2, WOUT_BYTES = (size_t)DM * FF * 2;
constexpr int CW_BAR = 4096, CW_TICK = 16384, CW_SS = 65536;
constexpr int BIAS_IN_LD = 2 * FF, BIAS_QKV_OFF = 4 * 9 * BIAS_IN_LD;
constexpr float ATT_QS = 0.088388347648318440f * 1.4426950408889634f;
constexpr size_t SHB_OFF = 393216;
constexpr int CW_HA = 240000;
constexpr size_t TAB_HM = 65536, TAB_PH = 327680, TAB_PHW = 655360;

constexpr int RING_BYTES = 131072, XCH_OFF = RING_BYTES  , MISC_OFF = RING_BYTES + 8192 + 320, LDS_BYTES = 147456;

typedef unsigned short bf16;
typedef unsigned v4u __attribute__((ext_vector_type(4)));
typedef unsigned v2u __attribute__((ext_vector_type(2)));
typedef float f32x4 __attribute__((ext_vector_type(4)));
#define LDS_WAIT() asm volatile("s_waitcnt lgkmcnt(0)" ::: "memory")
#define VM_WAIT() asm volatile("s_waitcnt vmcnt(0)" ::: "memory")
__device__ __forceinline__ unsigned f2bf(float f) { unsigned u = __builtin_bit_cast(unsigned, f); return (u + 0x7fffu + ((u >> 16) & 1u)) >> 16; }
__device__ __forceinline__ unsigned pk2(float lo, float hi) { return f2bf(lo) | (f2bf(hi) << 16); }
__device__ __forceinline__ unsigned cvt_pk_bf16(float lo, float hi) { unsigned r; asm volatile("v_cvt_pk_bf16_f32 %0, %1, %2" : "=v"(r) : "v"(lo), "v"(hi)); return r; }
__device__ __forceinline__ int lane_id() { unsigned m = ~0u; asm volatile("" : "+v"(m)); return (int)__builtin_amdgcn_mbcnt_hi(m, __builtin_amdgcn_mbcnt_lo(m, 0u)); }
__device__ __forceinline__ int lane_id_fresh() { unsigned m = ~0u; asm volatile("" : "+v"(m)); return (int)__builtin_amdgcn_mbcnt_hi(m, __builtin_amdgcn_mbcnt_lo(m, 0u)); }
__device__ __forceinline__ float wave_sum(float v) {
#pragma unroll
    for (int o = 1; o < 64; o <<= 1) v += __shfl_xor(v, o);
    return v;
}
__device__ __forceinline__ float silu_f(float g) { return g * __builtin_amdgcn_rcpf(1.0f + __builtin_amdgcn_exp2f(-1.4426950408889634f * g)); }

namespace pg8 {
typedef unsigned short bf16_t;
typedef short bf16x8 __attribute__((ext_vector_type(8)));
typedef float f32x4 __attribute__((ext_vector_type(4)));
typedef unsigned u32x4 __attribute__((ext_vector_type(4)));
constexpr int BM = 256, BK = 64, HALF = 128, HTB = HALF * BK * 2, STAGE_BYTES = 8 * HTB, NXCD = 8, WGM = 8;
__host__ __device__ __forceinline__ int lds_byte(int r, int c) { const int st = (r >> 4) * 2 + (c >> 5), rr = r & 15, cc = c & 31, ob = rr * 64 + cc * 2; return st * 1024 + (ob ^ (((ob >> 9) & 1) << 5)); }
__host__ __device__ __forceinline__ void stage_rc(int b, int& R, int& C) { const int st = b / 1024, sb = b % 1024, swz = sb ^ (((sb >> 9) & 1) << 5); R = (st >> 1) * 16 + swz / 64; C = (st & 1) * 32 + (swz % 64) / 2; }
__host__ __device__ __forceinline__ int perm32(int rho) { const int n = rho >> 4, i = rho & 15; return 8 * (i >> 2) + 4 * n + (i & 3); }

struct Unit { const char* A; const char* B; int nt, pm, pn, split; };

template <class Map> struct GridOrder {
    int nM, nN, nwg, G, c, wgm; Map map;
    __device__ __forceinline__ void init(int nM_, int nN_, int G_, int c_, const Map& m) { nM = nM_; nN = nN_; nwg = nM * nN; G = G_; asm volatile("" : "+s"(c_)); c = c_; map = m; wgm = WGM; }
    __device__ __forceinline__ void at(int L, Unit& u) const {
        int wgid = L; { const int q = nwg / NXCD, r = nwg % NXCD, xcd = wgid % NXCD, off = wgid / NXCD; wgid = (xcd < r ? xcd * (q + 1) : r * (q + 1) + (xcd - r) * q) + off; }
        const int nig = wgm * nN, gid = wgid / nig, fm = gid * wgm, gsz = (nM - fm) < wgm ? (nM - fm) : wgm;
        u.pm = fm + ((wgid % nig) % gsz); u.pn = (wgid % nig) / gsz; u.split = 0; map.fill(u);
    }
    __device__ __forceinline__ bool next(int i, Unit& u) const { const long L = (long)i * G + c; if (L >= nwg) return false; at((int)L, u); return true; }
};
struct MapPlain { const char* A; const char* B; unsigned astep, bstep; int nt, pm_off, pn_off;
    __device__ __forceinline__ void fill(Unit& u) const { u.A = A + (size_t)u.pm * astep; u.B = B + (size_t)u.pn * bstep; u.nt = nt; u.pm += pm_off; u.pn += pn_off; } };
struct ResidOrder { GridOrder<MapPlain> lat; int n_ctx; const char* Ac; unsigned ksplit; int nt_split;
    __device__ __forceinline__ bool next(int i, Unit& u) const {
        const long L = (long)i * lat.G + lat.c; if (L < lat.nwg) { lat.at((int)L, u); return true; }
        const int j = (int)(L - lat.nwg); if (j >= n_ctx) return false;
        const int ks = j >> 6, t = j & 63, pmc = t & 7, pn = t >> 3;
        u.A = Ac + (size_t)pmc * lat.map.astep + (size_t)ks * ksplit; u.B = lat.map.B + (size_t)pn * lat.map.bstep + (size_t)ks * ksplit; u.nt = nt_split; u.pm = ML / BM + pmc; u.pn = pn; u.split = ks + 1; return true; }
};
struct F1Order { int G, c; const char* Wc; const char* H;
    __device__ __forceinline__ bool next(int i, Unit& u) const {
        const long L = (long)i * G + c; int g, part, row0;
        if (L < 8 * 4 * 32) { const int pm = (int)L >> 5, pn = (int)L & 31; g = pm >> 2; part = pm & 3; row0 = (((pn >> 2) * 4 + part) * 1024) + (pn & 3) * 256; u.pm = pm; u.pn = pn; }
        else { const int j = (int)(L - 8 * 4 * 32); if (j >= 8 * 2 * 4) return false; g = j >> 3; const int cp = (j >> 2) & 1, tt = j & 3; part = 2 * cp; row0 = ML + cp * 1024 + tt * 256; u.pm = g * 4 + part; u.pn = 32 + tt; }
        u.A = Wc + (size_t)(part >= 2 ? 256 : 0) * 256 * 2; u.B = H + ((size_t)row0 * DM + g * 256) * 2; int n4 = 4; asm volatile("" : "+s"(n4)); u.nt = n4; u.split = 0; return true; }
};
struct MapF2 { const char* S; const char* P; size_t a_tile, p_batch, p_tile; int ktshift, nt, pm_off;
    __device__ __forceinline__ void fill(Unit& u) const { const int b = u.pm >> ktshift, kt = u.pm & ((1 << ktshift) - 1); u.A = S + (size_t)kt * a_tile; u.B = P + (size_t)b * p_batch + (size_t)u.pn * p_tile; u.nt = nt; u.pm += pm_off; } };

struct MapUV { const char* A2; const char* P;
    __device__ __forceinline__ void fill(Unit& u) const { const int b = u.pm >> 4, kind = (u.pm >> 2) & 3, kt = u.pm & 3;
        u.A = A2 + ((size_t)kind * 1024 + (size_t)kt * 256) * 1024 * 2; u.B = P + ((size_t)b * DM + (size_t)u.pn * 256) * 4096 * 2 + (size_t)kind * 1024 * 2; u.nt = 1024 / 64; } };

struct EpiSwiGLU {
    static constexpr bool PERM = true;
    bf16_t* HID; const float* ss; const float* bias;
    __device__ __forceinline__ void operator()(f32x4 (&acc)[2][2][4][2], const Unit& u, int wr, int wc, int fr, int fq, PG8_LAS unsigned char*) const {
        asm volatile("" : "+v"(fr), "+v"(fq));
        const int row0 = u.pm * BM + wr * 64 + fr, hc = u.pn * 128 + wc * 32 + 8 * fq;
        const int bp = u.pm < (ML / BM) ? (u.pm >> 4) : 8;
        const float* bq = bias + (size_t)bp * BIAS_IN_LD + u.pn * BM + wc * 32 + 8 * fq;
        const f32x4 bg0 = *(const f32x4*)bq, bg1 = *(const f32x4*)(bq + 4), bu0 = *(const f32x4*)(bq + HALF), bu1 = *(const f32x4*)(bq + HALF + 4);
        float rs[2][4];
#pragma unroll
        for (int ai = 0; ai < 2; ++ai)
#pragma unroll
            for (int m = 0; m < 4; ++m) rs[ai][m] = ss[row0 + ai * HALF + m * 16];
#pragma unroll
        for (int ai = 0; ai < 2; ++ai)
#pragma unroll
            for (int m = 0; m < 4; ++m) {
                const float r = __builtin_amdgcn_rsqf(rs[ai][m] * (1.0f / DM) + EPS);
                const f32x4 g0 = acc[ai][0][m][0] * r + bg0, g1 = acc[ai][0][m][1] * r + bg1, u0 = acc[ai][1][m][0] * r + bu0, u1 = acc[ai][1][m][1] * r + bu1;
                u32x4 w;
                w.x = cvt_pk_bf16(silu_f(g0[0]) * u0[0], silu_f(g0[1]) * u0[1]); w.y = cvt_pk_bf16(silu_f(g0[2]) * u0[2], silu_f(g0[3]) * u0[3]);
                w.z = cvt_pk_bf16(silu_f(g1[0]) * u1[0], silu_f(g1[1]) * u1[1]); w.w = cvt_pk_bf16(silu_f(g1[2]) * u1[2], silu_f(g1[3]) * u1[3]);
                *(u32x4*)(HID + (size_t)(row0 + ai * HALF + m * 16) * FF + hc) = w;
            }
    }
};
template <bool HALFC, bool NEXT, bool MIRROR = false> struct EpiResid {
    static constexpr bool PERM = true;
    const float* xin_l; const float* xin_c; float* xout_l; unsigned char* ws; int gate_off, tick_off;
    const float* ng; int nscale_off, ss_off;
    __device__ __forceinline__ void colvecs(f32x4 (&gv)[2][2], f32x4 (&vv)[2][2], const float* gb, unsigned c4, int bp) const {
#pragma unroll
        for (int bj = 0; bj < 2; ++bj)
#pragma unroll
            for (int n = 0; n < 2; ++n) { gv[bj][n] = *(const f32x4*)((const char*)gb + (size_t)(c4 + (unsigned)((bj * HALF + n * 4) * 4))); if (HALFC) gv[bj][n] *= 0.5f; }
        if constexpr (NEXT) { const float* sb = (const float*)(ws + WS_MOD) + nscale_off + (size_t)bp * MODLD;
#pragma unroll
            for (int bj = 0; bj < 2; ++bj)
#pragma unroll
                for (int n = 0; n < 2; ++n) { const unsigned o = c4 + (unsigned)((bj * HALF + n * 4) * 4); vv[bj][n] = *(const f32x4*)((const char*)ng + (size_t)o) * (*(const f32x4*)((const char*)sb + (size_t)o) + 1.0f); } }
    }
    __device__ __forceinline__ void loadg(f32x4 (&xv)[2][2], const float* xin, unsigned lo4, int roff) const {
        const unsigned o = lo4 + (unsigned)(roff * DM * 4);
#pragma unroll
        for (int bj = 0; bj < 2; ++bj)
#pragma unroll
            for (int n = 0; n < 2; ++n) xv[bj][n] = *(const f32x4*)((const char*)xin + (size_t)(o + (unsigned)((bj * HALF + n * 4) * 4)));
    }
    __device__ __forceinline__ void fing(const f32x4 (&q)[2][2], f32x4 (&xv)[2][2], float* xout, const f32x4 (&gv)[2][2], const f32x4 (&vv)[2][2], unsigned lo4, int roff, bf16_t* xs_t, float* ss_t, int rl0, int fq) const {
        const unsigned o = lo4 + (unsigned)(roff * DM * 4);
#pragma unroll
        for (int bj = 0; bj < 2; ++bj)
#pragma unroll
            for (int n = 0; n < 2; ++n) { xv[bj][n] += gv[bj][n] * q[bj][n]; *(f32x4*)((char*)xout + (size_t)(o + (unsigned)((bj * HALF + n * 4) * 4))) = xv[bj][n]; }
        if constexpr (NEXT) {
            float sq = 0.f;
#pragma unroll
            for (int bj = 0; bj < 2; ++bj) { const f32x4 x0 = xv[bj][0], x1 = xv[bj][1];
                sq += ((x0[0] * x0[0] + x0[1] * x0[1]) + (x0[2] * x0[2] + x0[3] * x0[3])) + ((x1[0] * x1[0] + x1[1] * x1[1]) + (x1[2] * x1[2] + x1[3] * x1[3]));
                const f32x4 y0 = x0 * vv[bj][0], y1 = x1 * vv[bj][1];
                u32x4 w; w.x = cvt_pk_bf16(y0[0], y0[1]); w.y = cvt_pk_bf16(y0[2], y0[3]); w.z = cvt_pk_bf16(y1[0], y1[1]); w.w = cvt_pk_bf16(y1[2], y1[3]);
                *(u32x4*)((char*)xs_t + (size_t)((o >> 1) + (unsigned)(bj * HALF * 2))) = w; }
            sq += __shfl_xor(sq, 16); sq += __shfl_xor(sq, 32);
            if (fq == 0) unsafeAtomicAdd((float*)((char*)ss_t + (size_t)((unsigned)(rl0 + roff) * 4u)), sq);
        }
        asm volatile("" ::: "memory");
    }
    template <int AI, int M> __device__ __forceinline__ void takeg(f32x4 (&q)[2][2], const f32x4 (&acc)[2][2][4][2]) const {
#pragma unroll
        for (int bj = 0; bj < 2; ++bj)
#pragma unroll
            for (int n = 0; n < 2; ++n) q[bj][n] = acc[AI][bj][M][n];
    }
    template <int AI, int MH> __device__ __forceinline__ void put_quarter(const f32x4 (&acc)[2][2][4][2], __amdgpu_buffer_rsrc_t rsrc, unsigned off) const {
#pragma unroll
        for (int mm = 0; mm < 2; ++mm)
#pragma unroll
            for (int bj = 0; bj < 2; ++bj)
#pragma unroll
                for (int n = 0; n < 2; ++n) __builtin_amdgcn_raw_buffer_store_b128(__builtin_bit_cast(u32x4, acc[AI][bj][2 * MH + mm][n]), rsrc, off + (unsigned)(((mm * 2 + bj) * 2 + n) * 1024), 0, 16);
    }
    template <int M, int SIGN> __device__ __forceinline__ void mrows(const f32x4 (&acc)[2][2][4][2], const f32x4 (&pc)[2][2], const f32x4 (&pd)[2][2], const float* special, int row, unsigned c4, float* xb, bf16_t* xsb, float* ssb,
                                                                      const f32x4 (&gv)[2][2], const f32x4 (&vv)[2][2], int fq) const {
        const unsigned o = (unsigned)row * (unsigned)(DM * 4) + c4; f32x4 xv[2][2];
#pragma unroll
        for (int bj = 0; bj < 2; ++bj)
#pragma unroll
            for (int n = 0; n < 2; ++n) xv[bj][n] = *(const f32x4*)((const char*)xb + (size_t)(o + (unsigned)((bj * HALF + n * 4) * 4)));
#pragma unroll
        for (int bj = 0; bj < 2; ++bj)
#pragma unroll
            for (int n = 0; n < 2; ++n) { f32x4 v = SIGN > 0 ? (acc[0][bj][M][n] + acc[1][bj][M][n]) + (pc[bj][n] + pd[bj][n]) : (acc[0][bj][M][n] - acc[1][bj][M][n]) + (pc[bj][n] - pd[bj][n]);
                if (SIGN > 0) { if (special) v = *(const f32x4*)((const char*)special + (size_t)(c4 + (unsigned)((bj * HALF + n * 4) * 4))); }
                xv[bj][n] += gv[bj][n] * v; *(f32x4*)((char*)xb + (size_t)(o + (unsigned)((bj * HALF + n * 4) * 4))) = xv[bj][n]; }
        float sq = 0.f;
#pragma unroll
        for (int bj = 0; bj < 2; ++bj) { const f32x4 x0 = xv[bj][0], x1 = xv[bj][1];
            sq += ((x0[0] * x0[0] + x0[1] * x0[1]) + (x0[2] * x0[2] + x0[3] * x0[3])) + ((x1[0] * x1[0] + x1[1] * x1[1]) + (x1[2] * x1[2] + x1[3] * x1[3]));
            const f32x4 y0 = x0 * vv[bj][0], y1 = x1 * vv[bj][1];
            u32x4 w; w.x = cvt_pk_bf16(y0[0], y0[1]); w.y = cvt_pk_bf16(y0[2], y0[3]); w.z = cvt_pk_bf16(y1[0], y1[1]); w.w = cvt_pk_bf16(y1[2], y1[3]);
            *(u32x4*)((char*)xsb + (size_t)((o >> 1) + (unsigned)(bj * HALF * 2))) = w; }
        sq += __shfl_xor(sq, 16); sq += __shfl_xor(sq, 32);
        if (fq == 0) unsafeAtomicAdd(ssb + row, sq);
        asm volatile("" ::: "memory");
    }
    __device__ __forceinline__ void mirror(const f32x4 (&acc)[2][2][4][2], const Unit& u, int wr, int wc, int fr, int fq, const float* gb) const {
        const int b = u.pm >> 4, par = (u.pm >> 3) & 1, jb = u.pm & 7, col0 = u.pn * BM + wc * 32 + 8 * fq; const unsigned c4 = (unsigned)col0 * 4u;
        float* xb = xout_l + (size_t)b * SEQ * DM; bf16_t* xsb = (bf16_t*)(ws + WS_H) + (size_t)b * SEQ * DM; float* ssb = (float*)(ws + WS_CTL) + ss_off + b * SEQ;
        const float* phw = (const float*)(ws + WS_TAB + TAB_PHW) + (size_t)b * DM; const float sk = par ? -1.0f : 1.0f, sj = (fr & 1) ? -1.0f : 1.0f;
        f32x4 gv[2][2], vv[2][2], pc[2][2], pd[2][2];
        colvecs(gv, vv, gb, c4, b);
#pragma unroll
        for (int bj = 0; bj < 2; ++bj)
#pragma unroll
            for (int n = 0; n < 2; ++n) { const size_t o = (size_t)(c4 + (unsigned)((bj * HALF + n * 4) * 4));
                const f32x4 c0 = *(const f32x4*)((const char*)phw + o), cx = *(const f32x4*)((const char*)(phw + (size_t)(par ? 24 : 16) * DM) + o);
                pc[bj][n] = c0 * sk + (par ? (f32x4){0.f, 0.f, 0.f, 0.f} : cx * sj); pd[bj][n] = par ? cx * sj : (f32x4){0.f, 0.f, 0.f, 0.f}; }
        const int k0 = 2 * (jb * 128 + wr * 64 + fr) + par;
#define MR(M) { const int k = k0 + 32 * M; mrows<M, -1>(acc, pc, pd, nullptr, k, c4, xb, xsb, ssb, gv, vv, fq); \
                mrows<M, 1>(acc, pc, pd, k == 0 ? phw + (size_t)8 * DM : nullptr, k == 0 ? SEQ / 2 : SEQ - k, c4, xb, xsb, ssb, gv, vv, fq); }
        MR(0) MR(1) MR(2) MR(3)
#undef MR
    }
    __device__ __forceinline__ void operator()(f32x4 (&acc)[2][2][4][2], const Unit& u, int wr, int wc, int fr, int fq, PG8_LAS unsigned char*) const {
        const bool lat = u.pm < (ML / BM); const int bp = lat ? (u.pm >> 4) : 8;
        const float* xin = lat ? xin_l + (size_t)u.pm * BM * DM : xin_c + (size_t)(u.pm - ML / BM) * BM * DM;
        float* xout = lat ? xout_l + (size_t)u.pm * BM * DM : (float*)(ws + WS_XC) + (size_t)(u.pm - ML / BM) * BM * DM;
        const float* gate = (const float*)(ws + WS_MOD) + gate_off; float* slab = (float*)(ws + WS_O); unsigned* tick = (unsigned*)(ws + WS_CTL) + tick_off;
        const float* gb = gate + (size_t)bp * MODLD;
        bf16_t* xs_t = (bf16_t*)(ws + WS_H) + (size_t)u.pm * BM * DM; float* ss_t = (float*)(ws + WS_CTL) + ss_off + u.pm * BM;
        if constexpr (MIRROR) { if (lat) { mirror(acc, u, wr, wc, fr, fq, gb); return; } }
        if (u.split == 0) {
            const int rl0 = wr * 64 + fr, col0 = u.pn * BM + wc * 32 + 8 * fq; const unsigned c4 = (unsigned)col0 * 4u, lo4 = (unsigned)(rl0 * DM + col0) * 4u;
            f32x4 gv[2][2], vv[2][2], q[2][2], x0[2][2];
            colvecs(gv, vv, gb, c4, bp);
#define RG(AI, M) loadg(x0, xin, lo4, AI * HALF + M * 16); takeg<AI, M>(q, acc); fing(q, x0, xout, gv, vv, lo4, AI * HALF + M * 16, xs_t, ss_t, rl0, fq);
            RG(0, 0) RG(0, 1) RG(0, 2) RG(0, 3) RG(1, 0) RG(1, 1) RG(1, 2) RG(1, 3)
#undef RG
            return; }
        const int ks = u.split - 1, t = (u.pm - ML / BM) + 8 * u.pn, wid = wr * 4 + wc;
        {
            const int lane = fq * 16 + fr;
            const unsigned long long sb = (unsigned long long)(slab + (size_t)(t * 4 + ks) * 65536);
            float* sbase = (float*)(((unsigned long long)(unsigned)__builtin_amdgcn_readfirstlane((int)(sb >> 32)) << 32) | (unsigned)__builtin_amdgcn_readfirstlane((int)(unsigned)sb));
            const __amdgpu_buffer_rsrc_t rsrc = __builtin_amdgcn_make_buffer_rsrc(sbase, 0, 262144, 0x00020000);
            const unsigned lo = (unsigned)(wid * 8192 + lane * 16);
            put_quarter<0, 0>(acc, rsrc, lo); put_quarter<0, 1>(acc, rsrc, 65536u + lo); put_quarter<1, 0>(acc, rsrc, 131072u + lo); put_quarter<1, 1>(acc, rsrc, 196608u + lo);
        }
        asm volatile("s_waitcnt vmcnt(0)" ::: "memory"); __builtin_amdgcn_s_barrier(); asm volatile("" ::: "memory");
        if (wid == 0 && lane_id() == 0) (void)__hip_atomic_fetch_add(tick + 64 * t, 1u, __ATOMIC_RELAXED, __HIP_MEMORY_SCOPE_AGENT);
    }
    __device__ __forceinline__ void finish_ctx(const Unit& u, int wave) const {
        const int ks = u.split - 1, t = (u.pm - ML / BM) + 8 * u.pn, wr = wave >> 2, wc = wave & 3;
        float* slab = (float*)(ws + WS_O); unsigned* tk = (unsigned*)(ws + WS_CTL) + tick_off + 64 * t;
        if (wave == 0 && lane_id() == 0) {
            unsigned sp = 0; while (__hip_atomic_load(tk, __ATOMIC_RELAXED, __HIP_MEMORY_SCOPE_AGENT) < 4u) { __builtin_amdgcn_s_sleep(2); if (++sp > (1u << 21)) break; }
            __builtin_amdgcn_fence(__ATOMIC_ACQUIRE, "agent");
        }
        asm volatile("s_waitcnt vmcnt(0)" ::: "memory"); __builtin_amdgcn_s_barrier(); asm volatile("" ::: "memory");
        const int l2 = lane_id(), fr = l2 & 15, fq = l2 >> 4, rl0 = wr * 64 + fr, col0 = u.pn * BM + wc * 32 + 8 * fq;
        const unsigned c4 = (unsigned)col0 * 4u, lo4 = (unsigned)(rl0 * DM + col0) * 4u, mo4 = (unsigned)(ks * 16384 + wave * 2048 + l2 * 4) * 4u;
        const float* xin = xin_c + (size_t)(u.pm - ML / BM) * BM * DM; float* xout = (float*)(ws + WS_XC) + (size_t)(u.pm - ML / BM) * BM * DM;
        const float* gb = (const float*)(ws + WS_MOD) + gate_off + (size_t)8 * MODLD;
        bf16_t* xs_t = (bf16_t*)(ws + WS_H) + (size_t)u.pm * BM * DM; float* ss_t = (float*)(ws + WS_CTL) + ss_off + u.pm * BM;
        f32x4 gv[2][2], vv[2][2];
        colvecs(gv, vv, gb, c4, 8);
#pragma unroll
        for (int mm = 0; mm < 2; ++mm) { const int roff = (ks >> 1) * HALF + (2 * (ks & 1) + mm) * 16;
            f32x4 xv[2][2], own[2][2], tv[4][2][2]; loadg(xv, xin, lo4, roff);
#pragma unroll
            for (int o = 0; o < 4; ++o) { const char* src = (const char*)(slab + ((size_t)t * 4 + o) * 65536);
#pragma unroll
                for (int bj = 0; bj < 2; ++bj)
#pragma unroll
                    for (int n = 0; n < 2; ++n) tv[o][bj][n] = *(const f32x4*)(src + (size_t)(mo4 + (unsigned)(((mm * 2 + bj) * 2 + n) * 1024))); }
#pragma unroll
            for (int bj = 0; bj < 2; ++bj)
#pragma unroll
                for (int n = 0; n < 2; ++n) own[bj][n] = (tv[0][bj][n] + tv[1][bj][n]) + (tv[2][bj][n] + tv[3][bj][n]);
            fing(own, xv, xout, gv, vv, lo4, roff, xs_t, ss_t, rl0, fq); }
    }
};
template <class EpiR> __device__ __forceinline__ void finish_split_units(const ResidOrder& S, const EpiR& E, int wave) {
    for (int i = 0;; ++i) { Unit u; if (!S.next(i, u)) break; if (u.split != 0) E.finish_ctx(u, wave); }
}
struct EpiF1 {
    static constexpr bool PERM = true;
    bf16_t* PQT; bf16_t* PQTC;
    __device__ __forceinline__ void operator()(f32x4 (&acc)[2][2][4][2], const Unit& u, int wr, int wc, int fr, int fq, PG8_LAS unsigned char*) const {
        const int g = u.pm >> 2, part = u.pm & 3; const bool lat = u.pn < 32;
        const int l0 = wr * 64 + fr, tc = wc * 32 + 8 * fq;
#pragma unroll
        for (int ai = 0; ai < 2; ++ai)
#pragma unroll
            for (int m = 0; m < 4; ++m) { const int l = g * 256 + l0 + ai * HALF + m * 16;
#pragma unroll
                for (int bj = 0; bj < 2; ++bj) { const f32x4 v0 = acc[ai][bj][m][0], v1 = acc[ai][bj][m][1];
                    u32x4 w; w.x = cvt_pk_bf16(v0[0], v0[1]); w.y = cvt_pk_bf16(v0[2], v0[3]); w.z = cvt_pk_bf16(v1[0], v1[1]); w.w = cvt_pk_bf16(v1[2], v1[3]);
                    const int t = tc + bj * HALF;
                    bf16_t* dst = lat ? PQT + ((size_t)((u.pn >> 2) * DM + l)) * 4096 + part * 1024 + (u.pn & 3) * 256 + t
                                      : PQTC + ((size_t)((2 * (u.pn - 32) + (t >> 7)) * DM + l)) * 256 + (part >> 1) * 128 + (t & 127);
                    *(u32x4*)dst = w; } }
    }
};
struct EpiBf16S {
    static constexpr bool PERM = true;
    bf16_t* O; int ldc; float scale;
    __device__ __forceinline__ void operator()(f32x4 (&acc)[2][2][4][2], const Unit& u, int wr, int wc, int fr, int fq, PG8_LAS unsigned char*) const {
        const int row0 = u.pm * BM + wr * 64 + fr, col0 = u.pn * BM + wc * 32 + 8 * fq;
#pragma unroll
        for (int ai = 0; ai < 2; ++ai)
#pragma unroll
            for (int m = 0; m < 4; ++m) { bf16_t* rowp = O + (size_t)(row0 + ai * HALF + m * 16) * ldc + col0;
#pragma unroll
                for (int bj = 0; bj < 2; ++bj) { const f32x4 v0 = acc[ai][bj][m][0] * scale, v1 = acc[ai][bj][m][1] * scale;
                    u32x4 w; w.x = cvt_pk_bf16(v0[0], v0[1]); w.y = cvt_pk_bf16(v0[2], v0[3]); w.z = cvt_pk_bf16(v1[0], v1[1]); w.w = cvt_pk_bf16(v1[2], v1[3]);
                    *(u32x4*)(rowp + bj * HALF) = w; } }
    }
};
struct EpiF2 {
    static constexpr bool PERM = true;
    bf16_t* O; const float* PH; float scale;
    __device__ __forceinline__ void operator()(f32x4 (&acc)[2][2][4][2], const Unit& u, int wr, int wc, int fr, int fq, PG8_LAS unsigned char*) const {
        const int bb = u.pm < (ML / BM) ? (u.pm >> 4) : (8 + u.pm - ML / BM);
        const int row0 = u.pm * BM + wr * 64 + fr, col0 = u.pn * BM + wc * 32 + 8 * fq;
        const float sg = (fr & 1) ? -1.0f : 1.0f;
        f32x4 ph[2][2];
#pragma unroll
        for (int bj = 0; bj < 2; ++bj)
#pragma unroll
            for (int n = 0; n < 2; ++n) ph[bj][n] = *(const f32x4*)(PH + (size_t)bb * DM + col0 + bj * HALF + 4 * n) * sg;
#pragma unroll
        for (int ai = 0; ai < 2; ++ai)
#pragma unroll
            for (int m = 0; m < 4; ++m) { bf16_t* rowp = O + (size_t)(row0 + ai * HALF + m * 16) * DM + col0;
#pragma unroll
                for (int bj = 0; bj < 2; ++bj) { const f32x4 v0 = (acc[ai][bj][m][0] + ph[bj][0]) * scale, v1 = (acc[ai][bj][m][1] + ph[bj][1]) * scale;
                    u32x4 w; w.x = cvt_pk_bf16(v0[0], v0[1]); w.y = cvt_pk_bf16(v0[2], v0[3]); w.z = cvt_pk_bf16(v1[0], v1[1]); w.w = cvt_pk_bf16(v1[2], v1[3]);
                    *(u32x4*)(rowp + bj * HALF) = w; } }
    }
};
struct EpiUV {
    static constexpr bool PERM = true;
    bf16_t* UV;
    __device__ __forceinline__ void operator()(f32x4 (&acc)[2][2][4][2], const Unit& u, int wr, int wc, int fr, int fq, PG8_LAS unsigned char*) const {
        const int b = u.pm >> 4, kind = (u.pm >> 2) & 3, kt = u.pm & 3, uv = kind >> 1, par = kind & 1, col0 = u.pn * BM + wc * 32 + 8 * fq;
#pragma unroll
        for (int ai = 0; ai < 2; ++ai)
#pragma unroll
            for (int m = 0; m < 4; ++m) { bf16_t* rowp = UV + ((size_t)(((b * 16 + par * 8 + kt * 2 + ai) * 2 + uv) * 128 + wr * 64 + m * 16 + fr)) * DM + col0;
#pragma unroll
                for (int bj = 0; bj < 2; ++bj) { const f32x4 v0 = acc[ai][bj][m][0] * (1.0f / 1024.0f), v1 = acc[ai][bj][m][1] * (1.0f / 1024.0f);
                    u32x4 w; w.x = cvt_pk_bf16(v0[0], v0[1]); w.y = cvt_pk_bf16(v0[2], v0[3]); w.z = cvt_pk_bf16(v1[0], v1[1]); w.w = cvt_pk_bf16(v1[2], v1[3]);
                    *(u32x4*)(rowp + bj * HALF) = w; } }
    }
};
struct EpiQKV {
    static constexpr bool PERM = true;
    bf16_t* Q; bf16_t* K; bf16_t* V; const float* tabc; const float* tabs; const float* gq; const float* gk; const float* ss; const float* bias;
    __device__ __forceinline__ void operator()(f32x4 (&acc)[2][2][4][2], const Unit& u, int wr, int wc, int fr, int fq, PG8_LAS unsigned char* lds) const {
        asm volatile("" : "+v"(fr), "+v"(fq));
        const bool lat = u.pm < (ML / BM);
        {
            const float* bq = bias + (size_t)(lat ? (u.pm >> 4) : 8) * NQKV + u.pn * BM + wc * 32 + 8 * fq;
            const f32x4 b00 = *(const f32x4*)bq, b01 = *(const f32x4*)(bq + 4), b10 = *(const f32x4*)(bq + HALF), b11 = *(const f32x4*)(bq + HALF + 4);
            const float* sr = ss + u.pm * BM + wr * 64 + fr;
#pragma unroll
            for (int ai = 0; ai < 2; ++ai)
#pragma unroll
                for (int m = 0; m < 4; ++m) { const float r = __builtin_amdgcn_rsqf(sr[ai * HALF + m * 16] * (1.0f / DM) + EPS);
                    acc[ai][0][m][0] = acc[ai][0][m][0] * r + b00; acc[ai][0][m][1] = acc[ai][0][m][1] * r + b01; acc[ai][1][m][0] = acc[ai][1][m][0] * r + b10; acc[ai][1][m][1] = acc[ai][1][m][1] * r + b11; }
        }
        const int b = lat ? (u.pm >> 4) : (u.pm - ML / BM);
        const int t0 = wc * 32 + 8 * fq;
        const int rl0 = wr * 64 + fr;
        if (u.pn >= 10) {
#pragma unroll
            for (int ai = 0; ai < 2; ++ai)
#pragma unroll
                for (int m = 0; m < 4; ++m) { const int rl = rl0 + ai * HALF + m * 16; const int kvrow = lat ? (CTXL + (u.pm & 15) * 256 + rl) : rl;
#pragma unroll
                    for (int bj = 0; bj < 2; ++bj) { const int kvh = 2 * (u.pn - 10) + bj; const f32x4 v0 = acc[ai][bj][m][0], v1 = acc[ai][bj][m][1];
                        u32x4 w; w.x = cvt_pk_bf16(v0[0], v0[1]); w.y = cvt_pk_bf16(v0[2], v0[3]); w.z = cvt_pk_bf16(v1[0], v1[1]); w.w = cvt_pk_bf16(v1[2], v1[3]);
                        *(u32x4*)(V + ((size_t)(b * NKV + kvh) * SKV + kvrow) * HD + t0) = w; } }
            return;
        }
        PG8_LAS float* T = (PG8_LAS float*)(lds + XCH_OFF);
        const bool isq = u.pn < 8;
        const float* gv = isq ? gq : gk;
        f32x4 ga = *(const f32x4*)(gv + t0), gb = *(const f32x4*)(gv + t0 + 4);
        if (isq) { ga *= ATT_QS; gb *= ATT_QS; }
        const int f0 = 16 * (wc & 1) + 4 * fq;
        f32x4 csv[2][4], snv[2][4];
#pragma unroll
        for (int ai = 0; ai < 2; ++ai)
#pragma unroll
            for (int m = 0; m < 4; ++m) { csv[ai][m] = (f32x4){1.f, 1.f, 1.f, 1.f}; snv[ai][m] = (f32x4){0.f, 0.f, 0.f, 0.f};
                if (lat) { const int s = (u.pm & 15) * 256 + rl0 + ai * HALF + m * 16; const int pos = (wc >> 1) ? (s & 63) : (s >> 6);
                    csv[ai][m] = *(const f32x4*)(tabc + pos * 32 + f0); snv[ai][m] = *(const f32x4*)(tabs + pos * 32 + f0); } }
#pragma unroll
        for (int ai = 0; ai < 2; ++ai)
#pragma unroll
            for (int m = 0; m < 4; ++m)
#pragma unroll
                for (int bj = 0; bj < 2; ++bj) { const f32x4 v0 = acc[ai][bj][m][0], v1 = acc[ai][bj][m][1];
                    float s = (v0[0] * v0[0] + v0[1] * v0[1]) + (v0[2] * v0[2] + v0[3] * v0[3]) + (v1[0] * v1[0] + v1[1] * v1[1]) + (v1[2] * v1[2] + v1[3] * v1[3]);
                    s += __shfl_xor(s, 16); s += __shfl_xor(s, 32);
                    if (fq == 0) T[(rl0 + ai * HALF + m * 16) * 8 + bj * 4 + wc] = s; }
        asm volatile("s_waitcnt lgkmcnt(0)" ::: "memory"); __builtin_amdgcn_s_barrier(); asm volatile("" ::: "memory");
#pragma unroll
        for (int ai = 0; ai < 2; ++ai)
#pragma unroll
            for (int m = 0; m < 4; ++m) { const int rl = rl0 + ai * HALF + m * 16;
                const f32x4 cs = csv[ai][m], sn = snv[ai][m];
#pragma unroll
                for (int bj = 0; bj < 2; ++bj) {
                    const f32x4 p4 = *(const PG8_LAS f32x4*)(T + rl * 8 + bj * 4);
                    const float rstd = 1.0f / sqrtf(((p4[0] + p4[1]) + (p4[2] + p4[3])) * (1.0f / 128.0f) + EPS);
                    const f32x4 y0 = acc[ai][bj][m][0] * rstd * ga, y1 = acc[ai][bj][m][1] * rstd * gb;
                    const float a0 = y0[0] * cs[0] - y0[1] * sn[0], a1 = y0[1] * cs[0] + y0[0] * sn[0];
                    const float a2 = y0[2] * cs[1] - y0[3] * sn[1], a3 = y0[3] * cs[1] + y0[2] * sn[1];
                    const float a4 = y1[0] * cs[2] - y1[1] * sn[2], a5 = y1[1] * cs[2] + y1[0] * sn[2];
                    const float a6 = y1[2] * cs[3] - y1[3] * sn[3], a7 = y1[3] * cs[3] + y1[2] * sn[3];
                    u32x4 w; w.x = cvt_pk_bf16(a0, a1); w.y = cvt_pk_bf16(a2, a3); w.z = cvt_pk_bf16(a4, a5); w.w = cvt_pk_bf16(a6, a7);
                    if (isq) { const int h = 2 * u.pn + bj; *(u32x4*)(Q + (size_t)(u.pm * BM + rl) * DM + h * HD + t0) = w; }
                    else { const int kvh = 2 * (u.pn - 8) + bj; const int kvrow = lat ? (CTXL + (u.pm & 15) * 256 + rl) : rl;
                        *(u32x4*)(K + ((size_t)(b * NKV + kvh) * SKV + kvrow) * HD + t0) = w; }
                } }
    }
};

template <class Epi, class Sched, bool ALIGN_EPI, bool SP2, int MODE = 0>
__device__ __forceinline__ void gemm_phase(PG8_LAS unsigned char* lds, const int lda, const int ldb, const Sched& S, const Epi& E, const int wave, const int first = 0, float* stag_slab = nullptr) {
    int tid_ = wave * 64 + lane_id_fresh(); asm volatile("" : "+v"(tid_));
    const int tid = tid_, wid = __builtin_amdgcn_readfirstlane(tid >> 6), lane = tid & 63, wr = wid >> 2, wc = wid & 3, fr = lane & 15, fq = lane >> 4;
    unsigned voffA[2], voffB[2];
#pragma unroll
    for (int i = 0; i < 2; ++i) { int R, C; stage_rc(tid * 16 + i * 8192, R, C); const int Rb = Epi::PERM ? ((R & ~31) + perm32(R & 31)) : R;
        voffA[i] = (unsigned)(R * lda + C) * 2u; voffB[i] = (unsigned)(Rb * ldb + C) * 2u; }
    const size_t kstep = (size_t)(BK * 2);
    const size_t hstepA = (size_t)HALF * lda * 2, hstepB = (size_t)HALF * ldb * 2;
    const unsigned ldsw = (unsigned)wid * 1024u;
    const int aoff = lds_byte(wr * 64 + fr, fq * 8), boff = lds_byte(wc * 32 + fr, fq * 8);
#define PG8_SA(b, h) (((b) * 2 + (h)) * HTB)
#define PG8_SB(b, h) ((4 + (b) * 2 + (h)) * HTB)
#define PG8_STAGE(bufoff, gbase, voff) do { const __amdgpu_buffer_rsrc_t r_ = __builtin_amdgcn_make_buffer_rsrc((void*)(gbase), 0, 0x7fffffff, 0x00020000); _Pragma("unroll") for (int _i = 0; _i < 2; ++_i) \
        __builtin_amdgcn_raw_ptr_buffer_load_lds(r_, (PG8_LAS void*)(lds + (bufoff) + ldsw + _i * 8192), 16, (voff)[_i], 0, 0, 0); } while (0)
#define PG8_LDA(dst, b, h) do { _Pragma("unroll") for (int m = 0; m < 4; ++m) _Pragma("unroll") for (int k = 0; k < 2; ++k) dst[m][k] = *(const PG8_LAS bf16x8*)(lds + PG8_SA(b, h) + aoff + m * 2048 + k * 1024); } while (0)
#define PG8_LDB(dst, b, h) do { _Pragma("unroll") for (int n = 0; n < 2; ++n) _Pragma("unroll") for (int k = 0; k < 2; ++k) dst[n][k] = *(const PG8_LAS bf16x8*)(lds + PG8_SB(b, h) + boff + n * 2048 + k * 1024); } while (0)
#define PG8_MMA(ai, bj, At, Bt) do { __builtin_amdgcn_s_setprio(1); _Pragma("unroll") for (int m = 0; m < 4; ++m) _Pragma("unroll") for (int n = 0; n < 2; ++n) _Pragma("unroll") for (int k = 0; k < 2; ++k) \
        acc[ai][bj][m][n] = __builtin_amdgcn_mfma_f32_16x16x32_bf16(Bt[n][k], At[m][k], acc[ai][bj][m][n], 0, 0, 0); __builtin_amdgcn_s_setprio(0); } while (0)
#define PG8_MMAZ(ai, bj, At, Bt) do { __builtin_amdgcn_s_setprio(1); _Pragma("unroll") for (int m = 0; m < 4; ++m) _Pragma("unroll") for (int n = 0; n < 2; ++n) { \
        acc[ai][bj][m][n] = __builtin_amdgcn_mfma_f32_16x16x32_bf16(Bt[n][0], At[m][0], (f32x4){0.f, 0.f, 0.f, 0.f}, 0, 0, 0); \
        acc[ai][bj][m][n] = __builtin_amdgcn_mfma_f32_16x16x32_bf16(Bt[n][1], At[m][1], acc[ai][bj][m][n], 0, 0, 0); } __builtin_amdgcn_s_setprio(0); } while (0)
#define PG8_WAIT_V(n) asm volatile("s_waitcnt vmcnt(" #n ")" ::: "memory")
#define PG8_WAIT_L(n) asm volatile("s_waitcnt lgkmcnt(" #n ")" ::: "memory")
#define PG8_BAR __builtin_amdgcn_s_barrier()
#define PG8_SCHED __builtin_amdgcn_sched_barrier(0)
    Unit cur, nxt; int ui = first;
    if (!S.next(first, cur)) return;
    constexpr bool ZFIRST = SP2 && MODE == 0;
    f32x4 acc[2][2][4][2];
#pragma unroll
    for (int a = 0; a < 2; ++a)
#pragma unroll
        for (int b = 0; b < 2; ++b)
#pragma unroll
            for (int m = 0; m < 4; ++m)
#pragma unroll
                for (int n = 0; n < 2; ++n) {
                    if constexpr (MODE == 2) acc[a][b][m][n] = __builtin_nontemporal_load((const f32x4*)((const char*)stag_slab + (size_t)((unsigned)(wid * 32768 + lane * 16) + (unsigned)((((a * 2 + b) * 4 + m) * 2 + n) * 1024))));
                    else if constexpr (!ZFIRST) acc[a][b][m][n] = (f32x4){0.f, 0.f, 0.f, 0.f}; }
    bf16x8 At[4][2], B0[2][2], B1[2][2];
    const char* cA = cur.A; const char* cB = cur.B;
    if constexpr (SP2) {
        PG8_STAGE(PG8_SB(0, 0), cB, voffB); PG8_STAGE(PG8_SB(0, 1), cB + hstepB, voffB); PG8_STAGE(PG8_SA(0, 0), cA, voffA); PG8_STAGE(PG8_SA(0, 1), cA + hstepA, voffA);
        if (wr == 1) PG8_BAR;
        PG8_WAIT_V(2); PG8_BAR;
        PG8_STAGE(PG8_SB(1, 0), cB + kstep, voffB); PG8_STAGE(PG8_SA(1, 0), cA + kstep, voffA); PG8_STAGE(PG8_SB(1, 1), cB + hstepB + kstep, voffB);
        PG8_WAIT_V(6); PG8_BAR;
    } else {
        PG8_STAGE(PG8_SB(0, 0), cB, voffB); PG8_STAGE(PG8_SA(0, 0), cA, voffA); PG8_STAGE(PG8_SB(0, 1), cB + hstepB, voffB); PG8_STAGE(PG8_SA(0, 1), cA + hstepA, voffA);
        if (wr == 1) PG8_BAR;
        PG8_WAIT_V(4); PG8_BAR;
        PG8_STAGE(PG8_SB(1, 0), cB + kstep, voffB); PG8_STAGE(PG8_SA(1, 0), cA + kstep, voffA); PG8_STAGE(PG8_SB(1, 1), cB + hstepB + kstep, voffB);
        PG8_WAIT_V(6); PG8_BAR;
    }
#define PG8_SP2BODY(MMAF) do { \
            PG8_LDB(B0, 0, 0); PG8_LDB(B1, 0, 1); PG8_SCHED; PG8_LDA(At, 0, 0); PG8_STAGE(PG8_SA(1, 1), a1 + hstepA, voffA); \
            PG8_WAIT_V(8); PG8_WAIT_L(0); PG8_BAR; MMAF(0, 0, At, B0); MMAF(0, 1, At, B1); PG8_BAR; PG8_SCHED; \
            PG8_LDA(At, 0, 1); PG8_STAGE(PG8_SB(0, 0), b2, voffB); PG8_STAGE(PG8_SB(0, 1), b2 + hstepB, voffB); PG8_STAGE(PG8_SA(0, 0), a2, voffA); \
            PG8_WAIT_V(8); PG8_WAIT_L(0); PG8_BAR; MMAF(1, 0, At, B0); MMAF(1, 1, At, B1); PG8_BAR; PG8_SCHED; \
            PG8_LDB(B0, 1, 0); PG8_LDB(B1, 1, 1); PG8_SCHED; PG8_LDA(At, 1, 0); PG8_STAGE(PG8_SA(0, 1), a2 + hstepA, voffA); \
            PG8_WAIT_V(8); PG8_WAIT_L(0); PG8_BAR; PG8_MMA(0, 0, At, B0); PG8_MMA(0, 1, At, B1); PG8_BAR; PG8_SCHED; \
            PG8_LDA(At, 1, 1); PG8_STAGE(PG8_SB(1, 0), b3, voffB); PG8_STAGE(PG8_SB(1, 1), b3 + hstepB, voffB); PG8_STAGE(PG8_SA(1, 0), a3, voffA); \
            PG8_WAIT_V(8); PG8_WAIT_L(0); PG8_BAR; PG8_MMA(1, 0, At, B0); PG8_MMA(1, 1, At, B1); PG8_BAR; PG8_SCHED; \
        } while (0)
    for (;;) {
        const bool has_next = S.next(ui + 1, nxt);
        const char* nA = has_next ? nxt.A : cA; const char* nB = has_next ? nxt.B : cB;
        const int nt = cur.nt;
        for (int t = 0; t < nt; t += 2) {
            const bool last = (t == nt - 2);
            const char* a1 = cA + (size_t)(t + 1) * kstep;
            const char* a2 = last ? nA : cA + (size_t)(t + 2) * kstep; const char* b2 = last ? nB : cB + (size_t)(t + 2) * kstep;
            const char* a3 = a2 + kstep; const char* b3 = b2 + kstep;
            if constexpr (SP2) {
            if (ZFIRST && t == 0) PG8_SP2BODY(PG8_MMAZ); else PG8_SP2BODY(PG8_MMA);
            } else {
            PG8_LDB(B0, 0, 0); PG8_SCHED; PG8_LDA(At, 0, 0); PG8_STAGE(PG8_SA(1, 1), a1 + hstepA, voffA);
            PG8_WAIT_L(8); PG8_BAR; PG8_WAIT_L(0); PG8_MMA(0, 0, At, B0); PG8_BAR; PG8_SCHED;
            PG8_LDB(B1, 0, 1); PG8_STAGE(PG8_SB(0, 0), b2, voffB);
            PG8_BAR; PG8_WAIT_L(0); PG8_MMA(0, 1, At, B1); PG8_BAR;
            PG8_LDA(At, 0, 1); PG8_STAGE(PG8_SA(0, 0), a2, voffA);
            PG8_BAR; PG8_WAIT_L(0); PG8_MMA(1, 0, At, B0); PG8_BAR; PG8_SCHED;
            PG8_STAGE(PG8_SB(0, 1), b2 + hstepB, voffB);
            PG8_WAIT_V(6); PG8_BAR; PG8_MMA(1, 1, At, B1); PG8_BAR;
            PG8_LDB(B0, 1, 0); PG8_SCHED; PG8_LDA(At, 1, 0); PG8_STAGE(PG8_SA(0, 1), a2 + hstepA, voffA);
            PG8_WAIT_L(8); PG8_BAR; PG8_WAIT_L(0); PG8_MMA(0, 0, At, B0); PG8_BAR; PG8_SCHED;
            PG8_LDB(B1, 1, 1); PG8_STAGE(PG8_SB(1, 0), b3, voffB);
            PG8_BAR; PG8_WAIT_L(0); PG8_MMA(0, 1, At, B1); PG8_BAR;
            PG8_LDA(At, 1, 1); PG8_STAGE(PG8_SA(1, 0), a3, voffA);
            PG8_BAR; PG8_WAIT_L(0); PG8_MMA(1, 0, At, B0); PG8_BAR; PG8_SCHED;
            PG8_STAGE(PG8_SB(1, 1), b3 + hstepB, voffB);
            PG8_WAIT_V(6); PG8_BAR; PG8_MMA(1, 1, At, B1); PG8_BAR;
            }
        }
        if constexpr (ALIGN_EPI) { if (wr == 0) PG8_BAR; }
        if constexpr (MODE == 1) { unsigned svo = (unsigned)(wid * 32768 + lane_id_fresh() * 16); asm volatile("" : "+v"(svo));
#pragma unroll
            for (int a = 0; a < 2; ++a)
#pragma unroll
                for (int b = 0; b < 2; ++b)
#pragma unroll
                    for (int m = 0; m < 4; ++m)
#pragma unroll
                        for (int n = 0; n < 2; ++n) *(f32x4*)((char*)stag_slab + (size_t)(svo + (unsigned)((((a * 2 + b) * 4 + m) * 2 + n) * 1024))) = acc[a][b][m][n];
        } else { const int le = lane_id_fresh(); E(acc, cur, wr, wc, le & 15, le >> 4, lds); }
        if (!has_next) break;
#pragma unroll
        for (int a = 0; a < 2; ++a)
#pragma unroll
            for (int b = 0; b < 2; ++b)
#pragma unroll
                for (int m = 0; m < 4; ++m)
#pragma unroll
                    for (int n = 0; n < 2; ++n) { if constexpr (!ZFIRST) acc[a][b][m][n] = (f32x4){0.f, 0.f, 0.f, 0.f}; }
        cur = nxt; cA = nA; cB = nB; ++ui;
        if constexpr (ALIGN_EPI) { if (wr == 1) PG8_BAR; }
    }
    PG8_WAIT_V(0);
    if constexpr (!ALIGN_EPI) { if (wr == 0) PG8_BAR; }
    PG8_BAR;
#undef PG8_SA
#undef PG8_SB
#undef PG8_STAGE
#undef PG8_LDA
#undef PG8_LDB
#undef PG8_MMA
#undef PG8_MMAZ
#undef PG8_SP2BODY
#undef PG8_WAIT_V
#undef PG8_WAIT_L
#undef PG8_BAR
#undef PG8_SCHED
}
struct OneUnit { Unit u; __device__ __forceinline__ bool next(int i, Unit& o) const { if (i != 0) return false; o = u; return true; } };
template <class Epi, class Sched, bool ALIGN_EPI, bool SP2>
__device__ __forceinline__ void gemm_phase_stag(PG8_LAS unsigned char* lds, const int lda, const int ldb, const Sched& S, const Epi& E, const int wave, float* stag_slab, bool stag) {
    if (stag) { Unit t; if (!S.next(0, t) || t.split != 0 || (t.nt & 3) != 0 || t.nt < 8) stag = false; }
    if (stag) { OneUnit s1; (void)S.next(0, s1.u); s1.u.nt >>= 1; gemm_phase<Epi, OneUnit, ALIGN_EPI, SP2, 1>(lds, lda, ldb, s1, E, wave, 0, stag_slab); }
    gemm_phase<Epi, Sched, ALIGN_EPI, SP2, 0>(lds, lda, ldb, S, E, wave, stag ? 1 : 0, stag_slab);
    if (stag) { OneUnit s2; (void)S.next(0, s2.u); const int h = s2.u.nt >> 1; s2.u.A += (size_t)h * (BK * 2); s2.u.B += (size_t)h * (BK * 2); s2.u.nt -= h;
        gemm_phase<Epi, OneUnit, ALIGN_EPI, SP2, 2>(lds, lda, ldb, s2, E, wave, 0, stag_slab); }
}
}

namespace att {
using bf16x8 = __attribute__((ext_vector_type(8))) short;
using s16x4  = __attribute__((ext_vector_type(4))) short;
using f32x16 = __attribute__((ext_vector_type(16))) float;
using u32x4  = __attribute__((ext_vector_type(4))) unsigned;
constexpr int D = 128, NW = 8, QBLK = 32, KVBLK = 64;
constexpr float SCALE = 0.088388347648318440f;
constexpr float THR = 8.f;
#ifndef ATTN_SDEPTH
#define ATTN_SDEPTH 1
#endif
constexpr int SDEPTH = ATTN_SDEPTH;
constexpr int LDQ = DM, LDK = HD, LDO = DM;
constexpr size_t SHM_V = KVBLK * D * 2, SHM_K = KVBLK * D * 2, SHM_ATTN = 4 * SHM_V + 4 * SHM_K + NW * 64 * 4;
#define KSWZ(row, colB) ((row) * 256 + ((colB) ^ (((row) & 7) << 4)))
#define SBAR() __builtin_amdgcn_sched_barrier(0)
__device__ __forceinline__ int crow(int r, int hi) { return (r & 3) + 8 * (r >> 2) + 4 * hi; }
__device__ __forceinline__ unsigned cvtpk(float lo, float hi) { unsigned r; asm volatile("v_cvt_pk_bf16_f32 %0, %1, %2" : "=v"(r) : "v"(lo), "v"(hi)); return r; }
template <bool NOMAX> __device__ __forceinline__ void partialSM(f32x16& p0, f32x16& p1, float& m_reg, float& mn, float& alpha) {
  if constexpr (NOMAX) { mn = m_reg; alpha = 1.f;
    for (int r = 0; r < 16; ++r) p0[r] = __builtin_amdgcn_exp2f(p0[r]); return; }
  float pmax = p0[0]; for (int r = 1; r < 16; ++r) pmax = fmaxf(pmax, p0[r]); for (int r = 0; r < 16; ++r) pmax = fmaxf(pmax, p1[r]);
  { auto rr = __builtin_amdgcn_permlane32_swap(__float_as_uint(pmax), __float_as_uint(pmax), false, false);
    pmax = fmaxf(__uint_as_float(rr[0]), __uint_as_float(rr[1])); }
  if (__builtin_expect(__all(pmax - m_reg <= THR * 1.4426950408889634f), 1)) { mn = m_reg; alpha = 1.f; }
  else { mn = fmaxf(m_reg, pmax); alpha = __builtin_amdgcn_exp2f(m_reg - mn); m_reg = mn; }
  for (int r = 0; r < 16; ++r) p0[r] = p0[r] - mn; for (int r = 0; r < 16; ++r) p1[r] = p1[r] - mn;
  for (int r = 0; r < 16; ++r) p0[r] = __builtin_amdgcn_exp2f(p0[r]);
}
__device__ __forceinline__ void finishSM(f32x16& p0, f32x16& p1, float alpha, float& l_reg, bf16x8& pa0, bf16x8& pa1, bf16x8& pa2, bf16x8& pa3) {
  for (int r = 0; r < 16; ++r) p1[r] = __builtin_amdgcn_exp2f(p1[r]);
  float ps = 0; for (int r = 0; r < 16; ++r) ps += p0[r]; for (int r = 0; r < 16; ++r) ps += p1[r];
  { auto rr = __builtin_amdgcn_permlane32_swap(__float_as_uint(ps), __float_as_uint(ps), false, false);
    ps = __uint_as_float(rr[0]) + __uint_as_float(rr[1]); }
  l_reg = l_reg * alpha + ps;
#define PK4(P, BASE, OUT) do { unsigned a0 = cvtpk(P[BASE + 0], P[BASE + 1]), a1 = cvtpk(P[BASE + 2], P[BASE + 3]);   \
    unsigned b0 = cvtpk(P[BASE + 4], P[BASE + 5]), b1 = cvtpk(P[BASE + 6], P[BASE + 7]);                              \
    auto r0 = __builtin_amdgcn_permlane32_swap(a0, b0, false, false); auto r1 = __builtin_amdgcn_permlane32_swap(a1, b1, false, false); \
    u32x4 w = {r0[0], r1[0], r0[1], r1[1]}; OUT = *reinterpret_cast<bf16x8*>(&w); } while (0)
  PK4(p0, 0, pa0); PK4(p0, 8, pa1); PK4(p1, 0, pa2); PK4(p1, 8, pa3);
#undef PK4
}
__device__ __forceinline__ void qkt(f32x16& p0, f32x16& p1, const bf16* Ks, const bf16x8* qr, int r32, int hi) {
  p0 = f32x16{}; p1 = f32x16{};
  for (int d0 = 0; d0 < 8; ++d0) { int cb = (d0 * 16 + hi * 8) * 2;
    bf16x8 b0 = *reinterpret_cast<const bf16x8*>((const char*)Ks + KSWZ(r32, cb));
    bf16x8 b1 = *reinterpret_cast<const bf16x8*>((const char*)Ks + KSWZ(32 + r32, cb));
    p0 = __builtin_amdgcn_mfma_f32_32x32x16_bf16(b0, qr[d0], p0, 0, 0, 0);
    p1 = __builtin_amdgcn_mfma_f32_32x32x16_bf16(b1, qr[d0], p1, 0, 0, 0); }
}
__device__ __forceinline__ int v_st(int k, int c) { const int kk = (k & ~0xC) | ((k & 4) << 1) | ((k & 8) >> 1); return ((kk >> 3) * 4 + (c >> 5)) * 512 + ((kk & 7) * 32 + (c & 31)) * 2; }
__device__ __forceinline__ int v_rd_base(int lane) { return ((lane & 3) << 3) | (((lane >> 2) & 3) << 6) | (((lane >> 4) & 1) << 5) | (((lane >> 5) & 1) << 8); }
constexpr int v_rd_off(int d0, int ks, int half) { return d0 * 512 + ks * 4096 + half * 2048; }
template <int OFF> __device__ __forceinline__ s16x4 tr_read(int vb) {
  s16x4 r; asm volatile("ds_read_b64_tr_b16 %0, %1 offset:%2" : "=&v"(r) : "v"(vb), "i"(OFF) : "memory"); return r;
}
template <int D0> __device__ __forceinline__ void pv_one(f32x16& od, int vb, bf16x8 pa0, bf16x8 pa1, bf16x8 pa2, bf16x8 pa3) {
  const s16x4 l0 = tr_read<v_rd_off(D0, 0, 0)>(vb), h0 = tr_read<v_rd_off(D0, 0, 1)>(vb), l1 = tr_read<v_rd_off(D0, 1, 0)>(vb), h1 = tr_read<v_rd_off(D0, 1, 1)>(vb);
  const s16x4 l2 = tr_read<v_rd_off(D0, 2, 0)>(vb), h2 = tr_read<v_rd_off(D0, 2, 1)>(vb), l3 = tr_read<v_rd_off(D0, 3, 0)>(vb), h3 = tr_read<v_rd_off(D0, 3, 1)>(vb);
  asm volatile("s_waitcnt lgkmcnt(0)" ::: "memory"); SBAR();
#define PK(L, H) (bf16x8){L[0], L[1], L[2], L[3], H[0], H[1], H[2], H[3]}
  od = __builtin_amdgcn_mfma_f32_32x32x16_bf16(pa0, PK(l0, h0), od, 0, 0, 0);
  od = __builtin_amdgcn_mfma_f32_32x32x16_bf16(pa1, PK(l1, h1), od, 0, 0, 0);
  od = __builtin_amdgcn_mfma_f32_32x32x16_bf16(pa2, PK(l2, h2), od, 0, 0, 0);
  od = __builtin_amdgcn_mfma_f32_32x32x16_bf16(pa3, PK(l3, h3), od, 0, 0, 0);
#undef PK
}
__device__ __forceinline__ void pv_d0(f32x16* o, int vb, bf16x8 pa0, bf16x8 pa1, bf16x8 pa2, bf16x8 pa3) {
  pv_one<0>(o[0], vb, pa0, pa1, pa2, pa3); pv_one<1>(o[1], vb, pa0, pa1, pa2, pa3); pv_one<2>(o[2], vb, pa0, pa1, pa2, pa3); pv_one<3>(o[3], vb, pa0, pa1, pa2, pa3);
}
template <bool NOMAX> __device__ __forceinline__ void attn_dense_body(const bf16* __restrict__ Qb, const bf16* __restrict__ Kh, const bf16* __restrict__ Vh, bf16* __restrict__ Ob, int seq, char* lds, const int wave, const float mbound) {
  int tid_ = wave * 64 + lane_id_fresh(); asm volatile("" : "+v"(tid_));
  const int tid = tid_, wid = tid >> 6, lane = tid & 63, r32 = lane & 31, hi = lane >> 5;
  bf16* V_lds = (bf16*)lds; bf16* K_lds = (bf16*)(lds + 4 * SHM_V);
  float* ws = (float*)(lds + 4 * SHM_V + 4 * SHM_K) + wid * 64; float* li_l = ws; float* al_l = ws + 32;
  float m_reg = NOMAX ? mbound : -1e30f, l_reg = 0; f32x16 o[4] = {}; bf16x8 qr[8];
  const bf16* Qw = Qb + (long)(wid * QBLK + r32) * LDQ + hi * 8;
#pragma unroll
  for (int d0 = 0; d0 < 8; ++d0) qr[d0] = *reinterpret_cast<const bf16x8*>(Qw + d0 * 16);
  const int sr = tid >> 4, sc = (tid & 15) * 8, vst0 = v_st(sr, sc), vst1 = v_st(32 + sr, sc);
  const int vb0 = (int)(uintptr_t)V_lds + v_rd_base(lane);
  struct { bf16x8 vs0, vs1, ks0, ks1; } sr_[SDEPTH];
#define LD8(p) (*reinterpret_cast<const bf16x8*>(p))
#define SLOAD(i, k0) do { sr_[i].vs0 = LD8(&Vh[(long)((k0) + sr) * LDK + sc]); sr_[i].vs1 = LD8(&Vh[(long)((k0) + 32 + sr) * LDK + sc]); \
    sr_[i].ks0 = LD8(&Kh[(long)((k0) + sr) * LDK + sc]); sr_[i].ks1 = LD8(&Kh[(long)((k0) + 32 + sr) * LDK + sc]); } while (0)
#define SWRITE(b, i) do { *(bf16x8*)((char*)V_lds + (b) * SHM_V + vst0) = sr_[i].vs0;          \
    *(bf16x8*)((char*)V_lds + (b) * SHM_V + vst1) = sr_[i].vs1; int kc = sc * 2;               \
    *(bf16x8*)((char*)K_lds + (b) * SHM_K + KSWZ(sr, kc)) = sr_[i].ks0;                       \
    *(bf16x8*)((char*)K_lds + (b) * SHM_K + KSWZ(32 + sr, kc)) = sr_[i].ks1; } while (0)
#define SWAIT() do { if constexpr (SDEPTH == 2) asm volatile("s_waitcnt vmcnt(4)" ::: "memory"); else asm volatile("s_waitcnt vmcnt(0)" ::: "memory"); } while (0)
#define RESC(a) do { if constexpr (!NOMAX) if (__any((a) < 1.f)) { if (hi == 0) al_l[r32] = (a); asm volatile("s_waitcnt lgkmcnt(0)" ::: "memory"); \
    for (int d = 0; d < 4; ++d) for (int r = 0; r < 16; ++r) o[d][r] *= al_l[crow(r, hi)]; } } while (0)
  f32x16 pA0, pA1, pB0, pB1; float mnA, mnB, alA, alB; bf16x8 pa0, pa1, pa2, pa3; const int NT = seq / KVBLK;
  constexpr int SE = 0, SO = SDEPTH - 1;
  static_assert(SDEPTH == 1, "ring form written for one staged tile");
  const bool isY = wave >= 4;
#define QL_ (lane_id_fresh())
  SLOAD(0, 0); asm volatile("s_waitcnt vmcnt(0)" ::: "memory"); SWRITE(0, 0); SLOAD(0, KVBLK); __syncthreads();
  qkt(pA0, pA1, K_lds, qr, QL_ & 31, QL_ >> 5);
  if (isY) { SWAIT(); SWRITE(1, 0); __syncthreads(); SLOAD(0, 2 * KVBLK); partialSM<NOMAX>(pA0, pA1, m_reg, mnA, alA); SWAIT(); SWRITE(2, 0); }
  else { partialSM<NOMAX>(pA0, pA1, m_reg, mnA, alA); SWAIT(); SWRITE(1, 0); __syncthreads(); }
  int sp = 0, sc_ = 1, sn = 2;
#define ROT() do { sp = sc_; sc_ = sn; sn = (sn + 1) & 3; } while (0)
#define ASTEP_X(PC0, PC1, PP0, PP1, ALP, MNC, ALC, TN) do {   \
    SBAR(); qkt(PC0, PC1, (bf16*)((char*)K_lds + sc_ * (int)SHM_K), qr, QL_ & 31, QL_ >> 5); \
    finishSM(PP0, PP1, ALP, l_reg, pa0, pa1, pa2, pa3); SBAR(); \
    SLOAD(0, (TN) * KVBLK); SBAR(); \
    pv_d0(o, vb0 + sp * (int)SHM_V, pa0, pa1, pa2, pa3); partialSM<NOMAX>(PC0, PC1, m_reg, MNC, ALC); \
    SWAIT(); SWRITE(sn, 0); \
    RESC(ALC); __syncthreads(); ROT(); } while (0)
#define ASTEP_Y(PC0, PC1, PP0, PP1, ALP, MNC, ALC, TN) do {   \
    SBAR(); qkt(PC0, PC1, (bf16*)((char*)K_lds + sc_ * (int)SHM_K), qr, QL_ & 31, QL_ >> 5); \
    finishSM(PP0, PP1, ALP, l_reg, pa0, pa1, pa2, pa3); SBAR(); \
    __syncthreads(); \
    if ((TN) + 1 < NT) SLOAD(0, ((TN) + 1) * KVBLK); \
    SBAR(); \
    pv_d0(o, vb0 + sp * (int)SHM_V, pa0, pa1, pa2, pa3); partialSM<NOMAX>(PC0, PC1, m_reg, MNC, ALC); \
    if ((TN) + 1 < NT) { SWAIT(); SWRITE((sn + 1) & 3, 0); } \
    RESC(ALC); ROT(); } while (0)
  if (isY) {
    for (int j = 1; j + 1 < NT; j += 2) {
      ASTEP_Y(pB0, pB1, pA0, pA1, alA, mnB, alB, j + 1);
      ASTEP_Y(pA0, pA1, pB0, pB1, alB, mnA, alA, j + 2);
    }
  } else {
    for (int j = 1; j + 1 < NT; j += 2) {
      ASTEP_X(pB0, pB1, pA0, pA1, alA, mnB, alB, j + 1);
      ASTEP_X(pA0, pA1, pB0, pB1, alB, mnA, alA, j + 2);
    }
  }
#undef ASTEP_X
#undef ASTEP_Y
  SBAR(); qkt(pB0, pB1, (bf16*)((char*)K_lds + sc_ * (int)SHM_K), qr, QL_ & 31, QL_ >> 5);
  finishSM(pA0, pA1, alA, l_reg, pa0, pa1, pa2, pa3); SBAR();
  pv_d0(o, vb0 + sp * (int)SHM_V, pa0, pa1, pa2, pa3); partialSM<NOMAX>(pB0, pB1, m_reg, mnB, alB);
  RESC(alB);
  finishSM(pB0, pB1, alB, l_reg, pa0, pa1, pa2, pa3); SBAR();
  pv_d0(o, vb0 + sc_ * (int)SHM_V, pa0, pa1, pa2, pa3);
#undef QL_
#undef ROT
  __syncthreads();
  { const int l2 = lane_id(), r32e = l2 & 31, hie = l2 >> 5;
  float* li_e = (float*)(lds + 4 * SHM_V + 4 * SHM_K) + wave * 64;
  if (hie == 0) li_e[r32e] = l_reg; asm volatile("s_waitcnt lgkmcnt(0)" ::: "memory");
  float rli[16];
#pragma unroll
  for (int r = 0; r < 16; ++r) rli[r] = __builtin_amdgcn_rcpf(li_e[crow(r, hie)]);
  char* ost = lds + wave * (32 * 272);
#pragma unroll
  for (int r = 0; r < 16; ++r) { const int orow = crow(r, hie);
#pragma unroll
    for (int d0 = 0; d0 < 4; ++d0) *(bf16*)(ost + orow * 272 + (d0 * 32 + r32e) * 2) = (bf16)f2bf(o[d0][r] * rli[r]); }
  asm volatile("s_waitcnt lgkmcnt(0)" ::: "memory");
  bf16* Ow = Ob + (long)(wave * QBLK) * LDO;
#pragma unroll
  for (int i = 0; i < 8; ++i) { const int ch = i * 64 + l2, orow = ch >> 4, c8 = (ch & 15) * 8;
    *reinterpret_cast<u32x4*>(Ow + (long)orow * LDO + c8) = *reinterpret_cast<const u32x4*>(ost + orow * 272 + c8 * 2); } }
  __syncthreads();
#undef LD8
#undef SLOAD
#undef SWRITE
#undef SWAIT
#undef RESC
}
}

#define XB_TMO      128
#define XB_XCNT(j)  (256  + 64 * (j))
#define XB_XSUB(j)  (1280 + 64 * (j))
#define XB_XGEN(j)  (2304 + 64 * (j))
#define XB_TOP      3328
#define XB_TOPGEN   3392
#define XCD_BAR_WORDS 3456
#define XB_SPIN_CAP (1u << 18)
__device__ __forceinline__ unsigned xb_ld(unsigned* p)              { return __hip_atomic_load(p, __ATOMIC_RELAXED, __HIP_MEMORY_SCOPE_AGENT); }
__device__ __forceinline__ unsigned xb_add(unsigned* p, unsigned v) { return __hip_atomic_fetch_add(p, v, __ATOMIC_RELAXED, __HIP_MEMORY_SCOPE_AGENT); }
__device__ __forceinline__ unsigned xb_xcc_id() { return (unsigned)__builtin_amdgcn_s_getreg((3 << 11) | 20) & 0xFu; }
#define XB_SPIN(cond, bar) do { unsigned _sp = 0; while (cond) { __builtin_amdgcn_s_sleep(1); \
    if ((++_sp & 255u) == 0u) { if (xb_ld(&(bar)[XB_TMO])) break; if (_sp > XB_SPIN_CAP) { atomicAdd(&(bar)[XB_TMO], 1u); break; } } } } while (0)
struct XcdBarrier { unsigned* bar; unsigned x; volatile LAS unsigned* st; int wave; };
__device__ __forceinline__ XcdBarrier xcd_barrier_post(unsigned* bar, volatile LAS unsigned* st, int wave) {
    XcdBarrier b; b.bar = bar; b.x = xb_xcc_id(); b.st = st; b.wave = wave;
    if (wave == 0 && lane_id() == 0) (void)xb_add(&bar[XB_XCNT(b.x)], 1u);
    return b;
}
__device__ __forceinline__ void xcd_barrier_complete(unsigned* bar, unsigned x, unsigned& nloc, unsigned& nx) {
    const unsigned G = gridDim.x * gridDim.y * gridDim.z;
    unsigned sum, cnt, mine, sp = 0u;
    for (;;) {
        sum = 0u; cnt = 0u; mine = 0u;
#pragma unroll
        for (unsigned j = 0; j < 16; ++j) { const unsigned c = xb_ld(&bar[XB_XCNT(j)]); sum += c; cnt += (c > 0u) ? 1u : 0u; mine = (j == x) ? c : mine; }
        if (sum == G) break;
        __builtin_amdgcn_s_sleep(1);
        if ((++sp & 255u) == 0u) { if (xb_ld(&bar[XB_TMO])) break; if (sp > XB_SPIN_CAP) { atomicAdd(&bar[XB_TMO], 1u); break; } }
    }
    nloc = mine > 0u ? mine : 1u; nx = cnt > 0u ? cnt : 1u;
}
__device__ __forceinline__ void xcd_barrier(const XcdBarrier& b) {
    asm volatile("s_waitcnt vmcnt(0)" ::: "memory");
    __syncthreads();
    if (b.wave == 0 && lane_id() == 0) {
        unsigned* bar = b.bar;
        __builtin_amdgcn_s_waitcnt(0);
        unsigned nloc = b.st[0], nx = b.st[1];
        if (nloc == 0u) { xcd_barrier_complete(bar, b.x, nloc, nx); b.st[0] = nloc; b.st[1] = nx; }
        const unsigned old = xb_add(&bar[XB_XSUB(b.x)], 1u);
        const unsigned gen = old / nloc;
        if (old + 1u == (gen + 1u) * nloc) {
            __builtin_amdgcn_fence(__ATOMIC_RELEASE, "agent");
            asm volatile("s_waitcnt vmcnt(0)" ::: "memory");
            const unsigned og = xb_add(&bar[XB_TOP], 1u);
            const unsigned tg = og / nx;
            if (og + 1u == (tg + 1u) * nx) xb_add(&bar[XB_TOPGEN], 1u);
            else XB_SPIN(xb_ld(&bar[XB_TOPGEN]) == tg, bar);
            __builtin_amdgcn_fence(__ATOMIC_ACQUIRE, "agent");
            xb_add(&bar[XB_XGEN(b.x)], 1u);
            asm volatile("s_waitcnt vmcnt(0)" ::: "memory");
        } else {
            XB_SPIN(xb_ld(&bar[XB_XGEN(b.x)]) == gen, bar);
            __builtin_amdgcn_fence(__ATOMIC_ACQUIRE, "agent");
            asm volatile("s_waitcnt vmcnt(0)" ::: "memory");
        }
    }
    __syncthreads();
}

template <int MODE> __device__ __forceinline__ int drow(int n) {
    if (MODE == 1) { const bool up = n >= FF; const int i = up ? n - FF : n; return (i >> 7) * 256 + (up ? 128 : 0) + (i & 127); }
    if (MODE == 2) { if (n >= 2560) return n; const int d = n & 127, a = d >> 6, w = d & 63, half = w >> 5, f = w & 31; return (n & ~127) + 2 * (a * 32 + f) + half; }
    return n;
}
template <int MODE> __device__ __forceinline__ void transpose_item(const float* W, int K, int N, bf16* WT, LAS float* scr, int item, int lane) {
    const int nblk = N / 64, kb = item / nblk, nb = item % nblk, k0 = 64 * kb, n0 = 64 * nb;
#pragma unroll
    for (int i = 0; i < 64; ++i) scr[i * 65 + lane] = W[(size_t)(k0 + i) * N + n0 + lane];
    LDS_WAIT(); asm volatile("" ::: "memory");
    const int c = lane & 7;
#pragma unroll
    for (int j = 0; j < 8; ++j) { const int n = (lane >> 3) + 8 * j; const LAS float* s = scr + (8 * c) * 65 + n;
        v4u o; o.x = pk2(s[0 * 65], s[1 * 65]); o.y = pk2(s[2 * 65], s[3 * 65]); o.z = pk2(s[4 * 65], s[5 * 65]); o.w = pk2(s[6 * 65], s[7 * 65]);
        *(GAS v4u*)(WT + (size_t)drow<MODE>(n0 + n) * K + k0 + 8 * c) = o; }
    LDS_WAIT(); asm volatile("" ::: "memory");
}
__device__ __forceinline__ void modulate_rows(const float* xl, const float* xc, int nrows, const float* ng, const float* shift, const float* scale, bf16* H, int gw, int NGW) {
    const int lane = lane_id();
    for (int row = gw; row < nrows; row += NGW) {
        const bool lat = row < ML; const int bp = lat ? (row >> 12) : 8;
        const float* src = lat ? xl + (size_t)row * DM : xc + (size_t)(row - ML) * DM;
        const GAS f32x4* xr = (const GAS f32x4*)src + lane;
        f32x4 v[8]; float s = 0.f;
#pragma unroll
        for (int j = 0; j < 8; ++j) { v[j] = xr[64 * j]; s += (v[j].x * v[j].x + v[j].y * v[j].y) + (v[j].z * v[j].z + v[j].w * v[j].w); }
        const float rstd = 1.0f / sqrtf(wave_sum(s) * (1.0f / DM) + EPS);
        const GAS f32x4* g4 = (const GAS f32x4*)ng + lane; const GAS f32x4* sh4 = (const GAS f32x4*)(shift + (size_t)bp * MODLD) + lane; const GAS f32x4* sc4 = (const GAS f32x4*)(scale + (size_t)bp * MODLD) + lane;
        GAS v2u* o8 = (GAS v2u*)(H + (size_t)row * DM) + lane;
#pragma unroll
        for (int j = 0; j < 8; ++j) { const f32x4 g = g4[64 * j], sh = sh4[64 * j], sc = sc4[64 * j];
            const f32x4 y = v[j] * rstd * g * (sc + 1.0f) + sh;
            v2u w; w.x = pk2(y.x, y.y); w.y = pk2(y.z, y.w); o8[64 * j] = w; }
    }
}

__device__ __forceinline__ void prep_rows(const float* xl, const float* xc, int nrows, const float* ng, const float* scale, bf16* XS, float* ss, int gw, int NGW) {
    const int lane = lane_id();
    f32x4 gg[8];
#pragma unroll
    for (int j = 0; j < 8; ++j) gg[j] = ((const GAS f32x4*)ng + lane)[64 * j];
    for (int row0 = 2 * gw; row0 < nrows; row0 += 2 * NGW) {
        const bool lat = row0 < ML;
        const GAS f32x4* xa = (const GAS f32x4*)(lat ? xl + (size_t)row0 * DM : xc + (size_t)(row0 - ML) * DM) + lane; const GAS f32x4* xb = xa + DM / 4;
        const GAS f32x4* sc4 = (const GAS f32x4*)(scale + (size_t)(lat ? (row0 >> 12) : 8) * MODLD) + lane;
        f32x4 va[8], vb[8], sc[8];
#pragma unroll
        for (int j = 0; j < 8; ++j) { va[j] = xa[64 * j]; vb[j] = xb[64 * j]; sc[j] = sc4[64 * j]; }
        GAS v2u* oa = (GAS v2u*)(XS + (size_t)row0 * DM) + lane; GAS v2u* ob = oa + DM / 4; float s0 = 0.f, s1 = 0.f;
#pragma unroll
        for (int j = 0; j < 8; ++j) { const f32x4 v = va[j], w = vb[j], m = gg[j] * (sc[j] + 1.0f);
            s0 += (v.x * v.x + v.y * v.y) + (v.z * v.z + v.w * v.w); s1 += (w.x * w.x + w.y * w.y) + (w.z * w.z + w.w * w.w);
            const f32x4 ya = v * m, yb = w * m;
            v2u pa, pb; pa.x = pk2(ya.x, ya.y); pa.y = pk2(ya.z, ya.w); pb.x = pk2(yb.x, yb.y); pb.y = pk2(yb.z, yb.w); oa[64 * j] = pa; ob[64 * j] = pb; }
        s0 = wave_sum(s0); s1 = wave_sum(s1); if (lane == 0) { ss[row0] = s0; ss[row0 + 1] = s1; }
    }
}
__device__ __forceinline__ void bias_gemv(const unsigned char* ws, const float* MOD, float* BIAS, int gw, int NGW) {
    typedef short bf16x8_t __attribute__((ext_vector_type(8)));
    const int lane = lane_id(), r16 = lane & 15, kq = lane >> 4;
    constexpr int B_IN = 2 * FF / 16, B_QKV = NQKV / 16, NITEM = 4 * B_IN + B_QKV, KQ = 4;
    asm volatile("" : "+v"(gw));
    for (int sub = gw; sub < NITEM * KQ; sub += NGW) {
        const int it = sub / KQ, q = sub % KQ;
        const int gi = it < 4 * B_IN ? it / B_IN : 4, n0 = (it - gi * B_IN) * 16;
        const bf16* W = gi < 4 ? (const bf16*)(ws + WS_WIN + (size_t)gi * WIN_BYTES) : (const bf16*)(ws + WS_WQKV);
        const int ldo = gi < 4 ? BIAS_IN_LD : NQKV; float* out = BIAS + (gi < 4 ? (size_t)gi * 9 * BIAS_IN_LD : (size_t)BIAS_QKV_OFF);
        const bf16* wp = W + (size_t)(n0 + r16) * DM + q * (DM / KQ) + kq * 8;
        const float* shift = MOD + (size_t)(gi < 4 ? (gi >> 1) : 1) * 9 * MODLD + (gi < 4 ? ((gi & 1) ? 6 : 0) : 3) * DM;
        const float* sp = shift + (size_t)(r16 < 9 ? r16 : 0) * MODLD + q * (DM / KQ) + kq * 8;
        f32x4 acc = (f32x4){0.f, 0.f, 0.f, 0.f};
#pragma unroll 8
        for (int ks = 0; ks < DM / 32 / KQ; ++ks) {
            const v4u wv = *(const GAS v4u*)(wp + ks * 32);
            f32x4 s0 = *(const GAS f32x4*)(sp + ks * 32), s1 = *(const GAS f32x4*)(sp + ks * 32 + 4);
            if (r16 >= 9) { s0 = (f32x4){0.f, 0.f, 0.f, 0.f}; s1 = s0; }
            v4u hi, lo;
            hi.x = pk2(s0.x, s0.y); hi.y = pk2(s0.z, s0.w); hi.z = pk2(s1.x, s1.y); hi.w = pk2(s1.z, s1.w);
            lo.x = pk2(s0.x - __uint_as_float(hi.x << 16), s0.y - __uint_as_float(hi.x & 0xffff0000u)); lo.y = pk2(s0.z - __uint_as_float(hi.y << 16), s0.w - __uint_as_float(hi.y & 0xffff0000u));
            lo.z = pk2(s1.x - __uint_as_float(hi.z << 16), s1.y - __uint_as_float(hi.z & 0xffff0000u)); lo.w = pk2(s1.z - __uint_as_float(hi.w << 16), s1.w - __uint_as_float(hi.w & 0xffff0000u));
            acc = __builtin_amdgcn_mfma_f32_16x16x32_bf16(__builtin_bit_cast(bf16x8_t, hi), __builtin_bit_cast(bf16x8_t, wv), acc, 0, 0, 0);
            acc = __builtin_amdgcn_mfma_f32_16x16x32_bf16(__builtin_bit_cast(bf16x8_t, lo), __builtin_bit_cast(bf16x8_t, wv), acc, 0, 0, 0);
        }
#pragma unroll
        for (int r = 0; r < 4; ++r) { const int bp = 4 * kq + r; if (bp < 9) (void)__hip_atomic_fetch_add(out + (size_t)bp * ldo + n0 + r16, acc[r], __ATOMIC_RELAXED, __HIP_MEMORY_SCOPE_AGENT); }
    }
}

__device__ __forceinline__ void phw_gemv(const float* PH, const bf16* WFOt, float* PHW, int wg, int nwg, int wave, LAS unsigned char* lds) {
    typedef short bf16x8_t __attribute__((ext_vector_type(8)));
    const int lane = lane_id(), r16 = lane & 15, kq = lane >> 4;
    LAS f32x4* part = (LAS f32x4*)lds;
    for (int it = wg; it < DM / 16; it += nwg) {
        const int n0 = it * 16;
        const bf16* wp = WFOt + (size_t)(n0 + r16) * DM + kq * 8 + wave * 256;
#pragma unroll
        for (int rb = 0; rb < 2; ++rb) {
            const int src0 = rb == 0 ? (r16 < 8 ? r16 : r16 + 8) : (r16 < 8 ? 24 + r16 : 24 + r16);
            const float* v0p = PH + (size_t)src0 * DM + kq * 8 + wave * 256; const float* v1p = PH + (size_t)(r16 & 7) * DM + kq * 8 + wave * 256;
            f32x4 acc = (f32x4){0.f, 0.f, 0.f, 0.f};
#pragma unroll
            for (int ks = 0; ks < 8; ++ks) {
                const v4u wv = *(const GAS v4u*)(wp + ks * 32);
                f32x4 s0 = *(const GAS f32x4*)(v0p + ks * 32), s1 = *(const GAS f32x4*)(v0p + ks * 32 + 4);
                if (rb == 0 && r16 >= 8) { s0 += *(const GAS f32x4*)(v1p + ks * 32); s1 += *(const GAS f32x4*)(v1p + ks * 32 + 4); }
                v4u hi, lo;
                hi.x = pk2(s0.x, s0.y); hi.y = pk2(s0.z, s0.w); hi.z = pk2(s1.x, s1.y); hi.w = pk2(s1.z, s1.w);
                lo.x = pk2(s0.x - __uint_as_float(hi.x << 16), s0.y - __uint_as_float(hi.x & 0xffff0000u)); lo.y = pk2(s0.z - __uint_as_float(hi.y << 16), s0.w - __uint_as_float(hi.y & 0xffff0000u));
                lo.z = pk2(s1.x - __uint_as_float(hi.z << 16), s1.y - __uint_as_float(hi.z & 0xffff0000u)); lo.w = pk2(s1.z - __uint_as_float(hi.w << 16), s1.w - __uint_as_float(hi.w & 0xffff0000u));
                acc = __builtin_amdgcn_mfma_f32_16x16x32_bf16(__builtin_bit_cast(bf16x8_t, hi), __builtin_bit_cast(bf16x8_t, wv), acc, 0, 0, 0);
                acc = __builtin_amdgcn_mfma_f32_16x16x32_bf16(__builtin_bit_cast(bf16x8_t, lo), __builtin_bit_cast(bf16x8_t, wv), acc, 0, 0, 0);
            }
            part[(rb * 8 + wave) * 64 + lane] = acc;
        }
        __syncthreads();
        if (wave < 2) { f32x4 t = part[(wave * 8) * 64 + lane];
#pragma unroll
            for (int w = 1; w < 8; ++w) t += part[(wave * 8 + w) * 64 + lane];
#pragma unroll
            for (int r = 0; r < 4; ++r) PHW[(size_t)(wave * 16 + 4 * kq + r) * DM + n0 + r16] = t[r] * (1.0f / 1024.0f); }
        __syncthreads();
    }
}

__device__ __forceinline__ void modrow(f32x4 (&y)[8], const float* row, const GAS f32x4* g4, const GAS f32x4* sh4, const GAS f32x4* sc4, int lane) {
    const GAS f32x4* xr = (const GAS f32x4*)row + lane; float s = 0.f;
#pragma unroll
    for (int q = 0; q < 8; ++q) { y[q] = xr[64 * q]; s += (y[q].x * y[q].x + y[q].y * y[q].y) + (y[q].z * y[q].z + y[q].w * y[q].w); }
    const float r = 1.0f / sqrtf(wave_sum(s) * (1.0f / DM) + EPS);
#pragma unroll
    for (int q = 0; q < 8; ++q) y[q] = y[q] * r * (g4[64 * q] * (sc4[64 * q] + 1.0f)) + sh4[64 * q];
}
__device__ __forceinline__ float ldrow(f32x4 (&y)[8], const float* row, int lane) {
    const GAS f32x4* xr = (const GAS f32x4*)row + lane; float s = 0.f;
#pragma unroll
    for (int q = 0; q < 8; ++q) y[q] = xr[64 * q];
#pragma unroll
    for (int q = 0; q < 8; ++q) s += (y[q].x * y[q].x + y[q].y * y[q].y) + (y[q].z * y[q].z + y[q].w * y[q].w);
    return s;
}
__device__ __forceinline__ void put_bf16_row(bf16* dst, const f32x4 (&y)[8], int lane) {
    GAS v2u* o = (GAS v2u*)dst + lane;
#pragma unroll
    for (int q = 0; q < 8; ++q) { v2u w; w.x = pk2(y[q].x, y[q].y); w.y = pk2(y[q].z, y[q].w); o[64 * q] = w; }
}
__device__ __forceinline__ void put_f32_row(float* dst, const f32x4 (&y)[8], int lane) {
    GAS f32x4* o = (GAS f32x4*)dst + lane;
#pragma unroll
    for (int q = 0; q < 8; ++q) o[64 * q] = y[q];
}
__device__ __forceinline__ void modulate_fold(const float* xl, const float* xc, const float* ng, const float* shift, const float* scale, bf16* H2, float* HM, float* HA, int gw, int NGW, LAS unsigned char* lds, int wave) {
    const int lane = lane_id();
    constexpr int M = SEQ / 2, NL = NB * (M / 2 + 1), NC = NB * (CTXL / 2 + 1);
    const int it0 = (int)(((long)gw * (NL + NC)) / NGW), it1 = (int)(((long)(gw + 1) * (NL + NC)) / NGW);
    LAS f32x4* hacc = (LAS f32x4*)lds + (size_t)(wave * 64 + lane) * 8;
    int hb = -1;
#pragma unroll
    for (int q = 0; q < 8; ++q) hacc[q] = (f32x4){0.f, 0.f, 0.f, 0.f};
#define HA_FLUSH() do { if (hb >= 0) { float* hp = HA + (size_t)hb * DM + lane * 4; _Pragma("unroll") for (int q = 0; q < 8; ++q) { const f32x4 hv = hacc[q]; unsafeAtomicAdd(hp + 256 * q + 0, hv.x); unsafeAtomicAdd(hp + 256 * q + 1, hv.y); unsafeAtomicAdd(hp + 256 * q + 2, hv.z); unsafeAtomicAdd(hp + 256 * q + 3, hv.w); hacc[q] = (f32x4){0.f, 0.f, 0.f, 0.f}; } } } while (0)
    for (int it = it0; it < it1; ++it) {
        int lane_ = lane; asm volatile("" : "+v"(lane_));
        const GAS f32x4* g4 = (const GAS f32x4*)ng + lane_;
        if (it < NL) {
            const int b = it / (M / 2 + 1), n = it - b * (M / 2 + 1);
            if (b != hb) { HA_FLUSH(); hb = b; }
            const float* base = xl + (size_t)b * SEQ * DM;
            const GAS f32x4* sh4 = (const GAS f32x4*)(shift + (size_t)b * MODLD) + lane_; const GAS f32x4* sc4 = (const GAS f32x4*)(scale + (size_t)b * MODLD) + lane_;
            bf16* p0 = H2 + ((size_t)(b * 4 + 0) * 1024 + n) * DM; const size_t pstep = (size_t)1024 * DM;
            f32x4 ya[8], yb[8];
            if (n == 0) {
                modrow(ya, base, g4, sh4, sc4, lane_); modrow(yb, base + (size_t)M * DM, g4, sh4, sc4, lane_);
                put_f32_row(HM + (size_t)b * DM, yb, lane_);
#pragma unroll
                for (int q = 0; q < 8; ++q) hacc[q] += ya[q];
                put_bf16_row(p0, ya, lane_); put_bf16_row(p0 + pstep, ya, lane_);
#pragma unroll
                for (int q = 0; q < 8; ++q) ya[q] = (f32x4){0.f, 0.f, 0.f, 0.f};
                put_bf16_row(p0 + 2 * pstep, ya, lane_); put_bf16_row(p0 + 3 * pstep, ya, lane_);
            } else if (n == M / 2) {
                modrow(ya, base + (size_t)(M / 2) * DM, g4, sh4, sc4, lane_); modrow(yb, base + (size_t)(M + M / 2) * DM, g4, sh4, sc4, lane_);
                f32x4 e[8], o[8];
#pragma unroll
                for (int q = 0; q < 8; ++q) { e[q] = ya[q] + yb[q]; o[q] = ya[q] - yb[q]; hacc[q] += e[q]; }
                put_f32_row(HM + (size_t)(16 + b) * DM, e, lane_); put_f32_row(HM + (size_t)(24 + b) * DM, o, lane_);
            } else {
                f32x4 yc[8], yd[8], gmv[8], shv[8];
#pragma unroll
                for (int q = 0; q < 8; ++q) { gmv[q] = g4[64 * q] * (sc4[64 * q] + 1.0f); shv[q] = sh4[64 * q]; }
                float sa = ldrow(ya, base + (size_t)n * DM, lane_), sb = ldrow(yb, base + (size_t)(SEQ - n) * DM, lane_), sc = ldrow(yc, base + (size_t)(M - n) * DM, lane_), sd = ldrow(yd, base + (size_t)(M + n) * DM, lane_);
#pragma unroll
                for (int o = 1; o < 64; o <<= 1) { sa += __shfl_xor(sa, o); sb += __shfl_xor(sb, o); sc += __shfl_xor(sc, o); sd += __shfl_xor(sd, o); }
                const float ra = 1.0f / sqrtf(sa * (1.0f / DM) + EPS), rb = 1.0f / sqrtf(sb * (1.0f / DM) + EPS), rc = 1.0f / sqrtf(sc * (1.0f / DM) + EPS), rd = 1.0f / sqrtf(sd * (1.0f / DM) + EPS);
                const float sgn = (n & 1) ? -1.0f : 1.0f;
#pragma unroll
                for (int q = 0; q < 8; ++q) { const f32x4 gm = gmv[q], sh = shv[q];
                    const f32x4 a = ya[q] * ra, b2 = yb[q] * rb, c2 = yc[q] * rc, d2 = yd[q] * rd;
                    const f32x4 hen = (a + b2) * gm + sh * 2.0f, hem = (c2 + d2) * gm + sh * 2.0f, hon = (a - b2) * gm, hom = (c2 - d2) * gm;
                    ya[q] = hen + hem; yb[q] = hen - hem; yc[q] = hon - hom; yd[q] = hon + hom; hacc[q] += ya[q] * sgn; }
                put_bf16_row(p0, ya, lane_); put_bf16_row(p0 + pstep, yb, lane_); put_bf16_row(p0 + 2 * pstep, yc, lane_); put_bf16_row(p0 + 3 * pstep, yd, lane_);
            }
        } else {
            const int j = it - NL, b = j / (CTXL / 2 + 1), n = j - b * (CTXL / 2 + 1);
            const float* base = xc + (size_t)b * CTXL * DM;
            const GAS f32x4* sh4 = (const GAS f32x4*)(shift + (size_t)8 * MODLD) + lane_; const GAS f32x4* sc4 = (const GAS f32x4*)(scale + (size_t)8 * MODLD) + lane_;
            f32x4 ya[8], yb[8];
            if (n == CTXL / 2) { modrow(ya, base + (size_t)n * DM, g4, sh4, sc4, lane_); put_f32_row(HM + (size_t)(8 + b) * DM, ya, lane_); }
            else { modrow(ya, base + (size_t)n * DM, g4, sh4, sc4, lane_);
                if (n == 0) {
#pragma unroll
                    for (int q = 0; q < 8; ++q) yb[q] = (f32x4){0.f, 0.f, 0.f, 0.f}; }
                else { modrow(yb, base + (size_t)(CTXL - n) * DM, g4, sh4, sc4, lane_);
#pragma unroll
                    for (int q = 0; q < 8; ++q) { const f32x4 e = ya[q] + yb[q], o = ya[q] - yb[q]; ya[q] = e; yb[q] = o; } }
                put_bf16_row(H2 + ((size_t)ML + 0 * 1024 + b * 128 + n) * DM, ya, lane_); put_bf16_row(H2 + ((size_t)ML + 1 * 1024 + b * 128 + n) * DM, yb, lane_); }
        }
    }
    HA_FLUSH();
#undef HA_FLUSH
}

struct Ctx { LAS unsigned char* lds; char* lds_gen; unsigned char* ws; int G, bx, vcu, gw, NGW, wave, lo, hi;
    const float* x_in; const float* ctx_in; const float* norm_g; float* X; float* XC; const float* MOD; const float* TABC; const float* TABS; const float* GQ; const float* GK; };
#define IN() (c.lo <= ph && ph < c.hi)
#ifdef PROBE_PHASE
#define SEAM() do { if (c.lo <= ph && ph + 1 < c.hi) xcd_barrier(bar); if (blockIdx.x == 0 && c.wave == 0 && lane_id() == 0) ((volatile LAS unsigned*)(c.lds + MISC_OFF))[17 + ph] = (unsigned)__builtin_amdgcn_s_memrealtime(); ++ph; } while (0)
#else
#define SEAM() do { if (c.lo <= ph && ph + 1 < c.hi) xcd_barrier(bar); ++ph; } while (0)
#endif
template <int f> __device__ __forceinline__ void macaron_step(const Ctx& c, const XcdBarrier& bar, int& ph) {
    LAS unsigned char* lds = c.lds; unsigned char* ws = c.ws; const int G = c.G, bx = c.bx, vcu = c.vcu, gw = c.gw, NGW = c.NGW;
    const float* x_in = c.x_in; const float* ctx_in = c.ctx_in; const float* norm_g = c.norm_g; float* X = c.X; float* XC = c.XC; const float* MOD = c.MOD;
    const float* TABC = c.TABC; const float* TABS = c.TABS; const float* GQ = c.GQ; const float* GK = c.GK;
    bf16* WCH = (bf16*)(ws + WS_WC); bf16* SEQC = WCH + 512 * 256; bf16* SEQM = (bf16*)(ws + WS_SEQ);
    bf16* WFO = (bf16*)(ws + WS_WFO); bf16* WQKV = (bf16*)(ws + WS_WQKV); bf16* WAO = (bf16*)(ws + WS_WAO);
    bf16* H = (bf16*)(ws + WS_H); bf16* HID = (bf16*)(ws + WS_HID); bf16* PQT = (bf16*)(ws + WS_PQT); bf16* PQTC = (bf16*)(ws + WS_PQTC);
    bf16* FB = (bf16*)(ws + WS_F); bf16* QB = (bf16*)(ws + WS_Q); bf16* KB = (bf16*)(ws + WS_K); bf16* VB = (bf16*)(ws + WS_V); bf16* OB = (bf16*)(ws + WS_O);
    float* SLAB = (float*)(ws + WS_O); unsigned* ctl = (unsigned*)(ws + WS_CTL); (void)SLAB; (void)ctl;
    float* HM = (float*)(ws + WS_TAB + TAB_HM); float* PH = (float*)(ws + WS_TAB + TAB_PH); (void)HM; (void)PH;
    (void)vcu; (void)WCH; (void)SEQC; (void)SEQM; (void)WFO; (void)WQKV; (void)WAO; (void)PQT; (void)PQTC; (void)FB; (void)QB; (void)KB; (void)VB; (void)OB; (void)TABC; (void)TABS; (void)GQ; (void)GK; (void)x_in; (void)ctx_in;
    const int ly = f >> 1, sub = f & 1;
    const float* modl = MOD + (size_t)ly * 9 * MODLD;
    const float* xs_l = (f == 0) ? x_in : X; const float* xs_c = (f == 0) ? ctx_in : XC;
    const int nMf = (f == 3) ? ML / 256 : MA / 256;
    float* SSB = (float*)(ws + WS_CTL) + CW_SS; float* BIAS = (float*)(ws + WS_BIAS);
    float* STG = (float*)(ws + (f == 0 ? WS_Q : WS_F)) + (size_t)bx * 65536; const bool stag_on = false;
    if constexpr (f == 0) {
        if (IN()) { bias_gemv(ws, MOD, BIAS, gw, NGW); prep_rows(x_in, ctx_in, MA, norm_g, modl + 1 * DM, H, SSB, gw, NGW); }
        SEAM();
    }
    if (IN()) {
        pg8::MapPlain mp{(const char*)H, (const char*)(ws + WS_WIN + (size_t)f * WIN_BYTES), 256u * DM * 2, 256u * DM * 2, DM / 64, 0, 0};
        pg8::GridOrder<pg8::MapPlain> S; S.init(nMf, 2 * FF / 256, G, bx, mp); S.wgm = 4;
        pg8::EpiSwiGLU E{HID, SSB + (size_t)(f == 3 ? 4 : f) * MA, BIAS + (size_t)f * 9 * BIAS_IN_LD};
        pg8::gemm_phase<pg8::EpiSwiGLU, pg8::GridOrder<pg8::MapPlain>, true, true>(lds, DM, DM, S, E, c.wave);
    }
    SEAM();
    if (IN()) {
        const char* wout = (const char*)(ws + WS_WOUT + (size_t)f * WOUT_BYTES);
        pg8::MapPlain mp{(const char*)HID, wout, 256u * FF * 2, 256u * FF * 2, FF / 64, 0, 0};
        pg8::ResidOrder S; S.lat.init(ML / 256, DM / 256, G, bx, mp); S.lat.wgm = 4; S.n_ctx = (f == 3) ? 0 : 256; S.Ac = (const char*)(HID + (size_t)ML * FF);
        S.ksplit = (unsigned)(FF / 4) * 2; S.nt_split = FF / 4 / 64;
        constexpr bool NX = (f == 1 || f == 2);
        pg8::EpiResid<true, NX> E{xs_l, xs_c, X, ws, ly * 9 * MODLD + (sub ? 8 : 2) * DM, CW_TICK + f * 64 * 64,
                                  norm_g + (size_t)(3 + (f == 2 ? 1 : 0)) * DM, 9 * MODLD + (f == 2 ? 4 : 1) * DM, CW_SS + (f == 2 ? 3 : 2) * MA};
        pg8::gemm_phase<pg8::EpiResid<true, NX>, pg8::ResidOrder, true, true>(lds, FF, FF, S, E, c.wave);
        pg8::finish_split_units(S, E, c.wave);
    }
    SEAM();
    if constexpr (f == 0) {
        if (IN()) modulate_fold(X, XC, norm_g + (size_t)(ly * 3 + 1) * DM, modl + 3 * DM, modl + 4 * DM, H, HM, (float*)(ws + WS_CTL) + CW_HA, gw, NGW, lds, c.wave);
        SEAM();
        if (IN()) {
            {
                const int gid = bx * 512 + c.wave * 64 + lane_id();
                if (gid < 40 * DM) { const int bb = gid >> 11, l = gid & 2047;
                    const float* src = bb < 16 ? HM + (size_t)bb * DM : (bb < 24 ? (const float*)(ws + WS_CTL) + CW_HA + (size_t)(bb - 16) * DM : HM + (size_t)(bb - 8) * DM);
                    const float* hm = src + (l & ~255); const bf16* wrow = WCH + (size_t)((bb >= 32 ? 256 : 0) + (l & 255)) * 256; float a = 0.f;
#pragma unroll 8
                    for (int c8 = 0; c8 < 256; c8 += 8) { const v4u w = *(const GAS v4u*)(wrow + c8); const f32x4 h0 = *(const GAS f32x4*)(hm + c8), h1 = *(const GAS f32x4*)(hm + c8 + 4);
                        a += h0.x * __uint_as_float(w.x << 16) + h0.y * __uint_as_float(w.x & 0xffff0000u) + h0.z * __uint_as_float(w.y << 16) + h0.w * __uint_as_float(w.y & 0xffff0000u)
                           + h1.x * __uint_as_float(w.z << 16) + h1.y * __uint_as_float(w.z & 0xffff0000u) + h1.z * __uint_as_float(w.w << 16) + h1.w * __uint_as_float(w.w & 0xffff0000u); }
                    PH[gid] = a; }
            }
            pg8::F1Order S; S.G = G; S.c = bx; S.Wc = (const char*)WCH; S.H = (const char*)H;
            pg8::EpiF1 E{PQT, PQTC};
            pg8::gemm_phase<pg8::EpiF1, pg8::F1Order, true, true>(lds, 256, DM, S, E, c.wave);
        }
        SEAM();
        if (IN()) {
            phw_gemv(PH, WFO, (float*)(ws + WS_TAB + TAB_PHW), (bx + G / 2) % G, G, c.wave, lds);
            {
                pg8::MapUV mp{(const char*)SEQM, (const char*)PQT};
                pg8::GridOrder<pg8::MapUV> S; S.init(ML / 256, DM / 256, G, bx, mp);
                pg8::EpiUV E{FB};
                pg8::gemm_phase<pg8::EpiUV, pg8::GridOrder<pg8::MapUV>, true, true>(lds, 1024, 4096, S, E, c.wave);
            }
            {
                pg8::MapF2 mp{(const char*)SEQC, (const char*)PQTC, (size_t)0, (size_t)DM * 256 * 2, (size_t)256 * 256 * 2, 0, 256 / 64, ML / 256};
                pg8::GridOrder<pg8::MapF2> S; S.init(NB, DM / 256, G, bx, mp);
                pg8::EpiF2 E{FB, PH, 1.0f / 256.0f};
                pg8::gemm_phase<pg8::EpiF2, pg8::GridOrder<pg8::MapF2>, true, true>(lds, 256, 256, S, E, c.wave);
            }
        }
        SEAM();
        if (IN()) {
            pg8::MapPlain mp{(const char*)FB, (const char*)WFO, 256u * DM * 2, 256u * DM * 2, DM / 64, 0, 0};
            pg8::ResidOrder S; S.lat.init(ML / 256, DM / 256, G, bx, mp); S.lat.wgm = 4; S.n_ctx = 256; S.Ac = (const char*)(FB + (size_t)ML * DM);
            S.ksplit = (unsigned)(DM / 4) * 2; S.nt_split = DM / 4 / 64;
            pg8::EpiResid<false, true, true> E{X, XC, X, ws, 5 * DM, CW_TICK + 3 * 64 * 64, norm_g + (size_t)2 * DM, 7 * DM, CW_SS + 1 * MA};
            pg8::gemm_phase<pg8::EpiResid<false, true, true>, pg8::ResidOrder, true, true>(lds, DM, DM, S, E, c.wave);
            pg8::finish_split_units(S, E, c.wave);
        }
        SEAM();
    }
    if constexpr (f == 2) {
        if (IN()) {
            pg8::EpiQKV E{QB, KB, VB, TABC, TABS, GQ, GK, SSB + (size_t)3 * MA, BIAS + BIAS_QKV_OFF};
            for (int part = 0; part < 2; ++part) {
                pg8::MapPlain mp = part == 0 ? pg8::MapPlain{(const char*)H, (const char*)WQKV, 256u * DM * 2, 256u * DM * 2, DM / 64, 0, 0}
                                             : pg8::MapPlain{(const char*)(H + (size_t)ML * DM), (const char*)(WQKV + (size_t)2048 * DM), 256u * DM * 2, 256u * DM * 2, DM / 64, ML / 256, 8};
                pg8::GridOrder<pg8::MapPlain> S; S.init(part == 0 ? ML / 256 : MC / 256, part == 0 ? 12 : 4, G, bx, mp);
                pg8::gemm_phase<pg8::EpiQKV, pg8::GridOrder<pg8::MapPlain>, true, true>(lds, DM, DM, S, E, c.wave);
            }
        }
        SEAM();
        if (IN()) {
            const float sbound = GK[128];
            for (int L = vcu; L < NB * NH * (SEQ / 256); L += G) {
                const int pair = L >> 6, wi = L & 63, b = pair >> 2, kvh = pair & 3, h = kvh * 4 + (wi >> 4), qb = wi & 15;
                const bf16* qp_ = QB + ((size_t)(b * SEQ + qb * 256)) * DM + h * HD; const bf16* kp_ = KB + (size_t)(b * NKV + kvh) * SKV * HD; const bf16* vp_ = VB + (size_t)(b * NKV + kvh) * SKV * HD;
                bf16* op_ = OB + ((size_t)(b * SEQ + qb * 256)) * DM + h * HD;
                if (sbound <= 43.0f) att::attn_dense_body<true>(qp_, kp_, vp_, op_, SKV, c.lds_gen, c.wave, sbound);
                else att::attn_dense_body<false>(qp_, kp_, vp_, op_, SKV, c.lds_gen, c.wave, 0.f);
            }
        }
        SEAM();
        if (IN()) {
            pg8::MapPlain mp{(const char*)OB, (const char*)WAO, 256u * DM * 2, 256u * DM * 2, DM / 64, 0, 0};
            pg8::GridOrder<pg8::MapPlain> S; S.init(ML / 256, DM / 256, G, bx, mp); S.wgm = 4;
            pg8::EpiResid<false, true> E{X, XC, X, ws, 9 * MODLD + 5 * DM, 0, norm_g + (size_t)5 * DM, 9 * MODLD + 7 * DM, CW_SS + 4 * MA};
            pg8::gemm_phase<pg8::EpiResid<false, true>, pg8::GridOrder<pg8::MapPlain>, true, true>(lds, DM, DM, S, E, c.wave);
        }
        SEAM();
    }
}
#undef IN
#undef SEAM

struct Args { const float* in[14]; float* out; unsigned char* ws; int ph_lo, ph_hi; };
constexpr int N_PHASES = 17;

__global__ void __launch_bounds__(512, 2) fwd(Args args) {
    extern __shared__ __attribute__((aligned(16))) unsigned char lds_raw[];
    LAS unsigned char* lds = (LAS unsigned char*)lds_raw;
    volatile LAS unsigned* MISC = (volatile LAS unsigned*)(lds + MISC_OFF);
    const int tid = threadIdx.x, lane = tid & 63, wave = __builtin_amdgcn_readfirstlane(tid >> 6);
    const int G = gridDim.x, bx = blockIdx.x;
    const int vcu = (G % 8 == 0) ? (bx % 8) * (G / 8) + bx / 8 : bx;
    unsigned char* ws = args.ws;
    unsigned* ctl = (unsigned*)(ws + WS_CTL);
    const float* x_in = args.in[0]; const float* ctx_in = args.in[2]; const float* norm_g = args.in[6];
#define KARG(i) ([&]() { const __attribute__((address_space(4))) Args* ap_ = (const __attribute__((address_space(4))) Args*)__builtin_amdgcn_kernarg_segment_ptr(); asm volatile("" : "+s"(ap_)); return ap_->in[i]; }())
    float* X = args.out; float* XC = (float*)(ws + WS_XC);
    float* MOD = (float*)(ws + WS_MOD);
    float* TABC = (float*)(ws + WS_TAB); float* TABS = TABC + 2048; float* GQ = TABS + 2048; float* GK = GQ + 128;
    bf16* WCH = (bf16*)(ws + WS_WC); bf16* SEQC = WCH + 512 * 256; bf16* SEQM = (bf16*)(ws + WS_SEQ);
    bf16* WFO = (bf16*)(ws + WS_WFO); bf16* WQKV = (bf16*)(ws + WS_WQKV); bf16* WAO = (bf16*)(ws + WS_WAO);
    bf16* H = (bf16*)(ws + WS_H); bf16* HID = (bf16*)(ws + WS_HID); bf16* PQT = (bf16*)(ws + WS_PQT); bf16* PQTC = (bf16*)(ws + WS_PQTC);
    bf16* FB = (bf16*)(ws + WS_F); bf16* QB = (bf16*)(ws + WS_Q); bf16* KB = (bf16*)(ws + WS_K); bf16* VB = (bf16*)(ws + WS_V); bf16* OB = (bf16*)(ws + WS_O);

    for (int u = tid; u < (LDS_BYTES - RING_BYTES) / 4; u += 512) ((LAS unsigned*)(lds + RING_BYTES))[u] = 0u;
    __syncthreads();
    const int lo = args.ph_lo, hi = args.ph_hi;
    XcdBarrier bar; bar.bar = ctl + CW_BAR; bar.x = 0; bar.st = MISC + 8; bar.wave = wave;
    if (hi - lo > 1) bar = xcd_barrier_post(ctl + CW_BAR, MISC + 8, wave);
    int ph = 0;
#define IN() (lo <= ph && ph < hi)
#ifdef PROBE_PHASE
    if (bx == 0 && tid == 0) MISC[16] = (unsigned)__builtin_amdgcn_s_memrealtime();
#define SEAM() do { if (lo <= ph && ph + 1 < hi) xcd_barrier(bar); if (bx == 0 && tid == 0) MISC[17 + ph] = (unsigned)__builtin_amdgcn_s_memrealtime(); ++ph; } while (0)
#else
#define SEAM() do { if (lo <= ph && ph + 1 < hi) xcd_barrier(bar); ++ph; } while (0)
#endif
    const int gw = vcu * 8 + wave, NGW = G * 8;

    if (IN()) {
        LAS float* lut = (LAS float*)lds;
        for (int j = tid; j < 4096; j += 512) lut[j] = cospif((float)j * (1.0f / 2048.0f));
        __syncthreads();
        {
            const int nchunk = 4 * 1024 * 128;
            for (int ch = bx * 512 + tid; ch < nchunk; ch += G * 512) { const int kind = ch >> 17, j = (ch >> 7) & 1023, n8 = (ch & 127) * 8, kk = 2 * j + (kind & 1), ph0 = (kind & 2) ? 3072 : 0; unsigned w[4];
#pragma unroll
                for (int e = 0; e < 4; ++e) { const int n0 = n8 + 2 * e, n1 = n0 + 1; w[e] = pk2(lut[(kk * n0 + ph0) & 4095], lut[(kk * n1 + ph0) & 4095]); }
                *(GAS v4u*)(SEQM + (size_t)ch * 8) = (v4u){w[0], w[1], w[2], w[3]}; }
            for (int e = bx * 512 + tid; e < 256 * 256; e += G * 512) { const int k = e >> 8, n = e & 255;
                SEQC[e] = (bf16)f2bf(lut[n < 128 ? (k * n * 16) & 4095 : (k * (n - 128) * 16 + 1024) & 4095]); }
            for (int e = bx * 512 + tid; e < 512 * 256; e += G * 512) { const int l = e >> 8, c = e & 255;
                WCH[e] = (bf16)f2bf(lut[l < 256 ? (l * c * 16) & 4095 : ((l - 256) * c * 16 + 3072) & 4095]); }
        }
        for (int i = bx * 512 + tid; i < (4 * 9 * BIAS_IN_LD + 9 * NQKV) / 4; i += G * 512) ((GAS f32x4*)(ws + WS_BIAS))[i] = (f32x4){0.f, 0.f, 0.f, 0.f};
        if (bx == 0) {
            for (int t = tid; t < 2048; t += 512) { const int pos = t >> 5, f = t & 31; const double inv = pow(10000.0, -(double)f / 32.0), ang = (double)pos * inv;
                TABC[t] = (float)cos(ang); TABS[t] = (float)sin(ang); }
            if (tid < 128) { const int i = tid >> 1, hf = tid & 1, d = (i < 32 ? i : i + 32) + 32 * hf; const float* qng = KARG(11); const float* kng = KARG(12); GQ[tid] = qng[d]; GK[tid] = kng[d];
                if (tid == 0) { float mq = 0.f, mk = 0.f; for (int e = 0; e < HD; ++e) { mq = fmaxf(mq, fabsf(qng[e])); mk = fmaxf(mk, fabsf(kng[e])); } GK[128] = (float)HD * mq * mk * ATT_QS; } }
        }
        __syncthreads();
        {
            LAS float* s_sh = (LAS float*)lds;
            LAS float* red = (LAS float*)(lds + 81920);
            const float* c_in = KARG(1); const float* cctx_in = KARG(3); const float* w_ada = KARG(4); const float* b_ada = KARG(5);
            for (int i = tid; i < 9 * DM; i += 512) { const int bp = i >> 11, k = i & 2047; const float cv = bp < 8 ? c_in[bp * DM + k] : cctx_in[k]; s_sh[i] = cv / (1.0f + expf(-cv)); }
            __syncthreads();
            const int cg = lane & 7, ksl = wave * 8 + (lane >> 3), k0 = ksl * 32;
            for (int it = bx; it < 2 * 576; it += G) {
                const int ly = it / 576, j0 = (it % 576) * 32;
                const float* wp = w_ada + (size_t)ly * DM * MODLD + (size_t)k0 * MODLD + j0 + 4 * cg;
                f32x4 a[9];
#pragma unroll
                for (int b = 0; b < 9; ++b) a[b] = (f32x4){0.f, 0.f, 0.f, 0.f};
                for (int kk = 0; kk < 32; kk += 4) {
                    const f32x4 w0 = *(const GAS f32x4*)(wp + (size_t)(kk + 0) * MODLD), w1 = *(const GAS f32x4*)(wp + (size_t)(kk + 1) * MODLD);
                    const f32x4 w2 = *(const GAS f32x4*)(wp + (size_t)(kk + 2) * MODLD), w3 = *(const GAS f32x4*)(wp + (size_t)(kk + 3) * MODLD);
#pragma unroll
                    for (int b = 0; b < 9; ++b) { const f32x4 s4 = *(const LAS f32x4*)(s_sh + b * DM + k0 + kk); a[b] += w0 * s4.x + w1 * s4.y + w2 * s4.z + w3 * s4.w; }
                }
#pragma unroll
                for (int b = 0; b < 9; ++b)
#pragma unroll
                    for (int e = 0; e < 4; ++e) { float v = a[b][e]; v += __shfl_xor(v, 8); v += __shfl_xor(v, 16); v += __shfl_xor(v, 32); a[b][e] = v; }
                if (lane < 8) {
#pragma unroll
                    for (int b = 0; b < 9; ++b) *(LAS f32x4*)(red + (wave * 8 + cg) * 36 + b * 4) = a[b]; }
                __syncthreads();
                if (tid < 288) { const int bp = tid >> 5, jj = tid & 31; float v = b_ada[(size_t)ly * MODLD + j0 + jj];
#pragma unroll
                    for (int w = 0; w < 8; ++w) v += red[(w * 8 + (jj >> 2)) * 36 + bp * 4 + (jj & 3)];
                    MOD[((size_t)ly * 9 + bp) * MODLD + j0 + jj] = v; }
                __syncthreads();
            }
        }
        {
            LAS float* scr = (LAS float*)(lds + wave * 17408);
            constexpr int I_IN = (DM / 64) * (2 * FF / 64), I_OUT = (FF / 64) * (DM / 64), I_SQ = (DM / 64) * (DM / 64), I_QKV = (DM / 64) * (NQKV / 64);
            static_assert(8 * 17408 <= MISC_OFF && 64 * 65 * 4 <= 17408, "transpose scratch");
            constexpr int NITEMS = 4 * I_IN + 4 * I_OUT + 2 * I_SQ + I_QKV;
            const float* w_ffn_in = KARG(7); const float* w_ffn_out = KARG(8); const float* w_fo = KARG(9); const float* w_qkv = KARG(10); const float* w_ao = KARG(13);
            for (int it = gw; it < NITEMS; it += NGW) {
                int r = NITEMS - 1 - it;
                if (r < 4 * I_IN) { const int f = r / I_IN; transpose_item<1>(w_ffn_in + (size_t)f * DM * 2 * FF, DM, 2 * FF, (bf16*)(ws + WS_WIN + (size_t)f * WIN_BYTES), scr, r % I_IN, lane); continue; } r -= 4 * I_IN;
                if (r < 4 * I_OUT) { const int f = r / I_OUT; transpose_item<0>(w_ffn_out + (size_t)f * FF * DM, FF, DM, (bf16*)(ws + WS_WOUT + (size_t)f * WOUT_BYTES), scr, r % I_OUT, lane); continue; } r -= 4 * I_OUT;
                if (r < I_SQ) { transpose_item<0>(w_fo, DM, DM, WFO, scr, r, lane); continue; } r -= I_SQ;
                if (r < I_SQ) { transpose_item<0>(w_ao, DM, DM, WAO, scr, r, lane); continue; } r -= I_SQ;
                transpose_item<2>(w_qkv, DM, NQKV, WQKV, scr, r, lane);
            }
        }
    }
    SEAM();

    {
        Ctx c; c.lds = lds; c.lds_gen = (char*)lds_raw; c.ws = ws; c.G = G; c.bx = bx; c.vcu = vcu; c.gw = gw; c.NGW = NGW; c.wave = wave; c.lo = lo; c.hi = hi;
        c.x_in = x_in; c.ctx_in = ctx_in; c.norm_g = norm_g; c.X = X; c.XC = XC; c.MOD = MOD; c.TABC = TABC; c.TABS = TABS; c.GQ = GQ; c.GK = GK;
        macaron_step<0>(c, bar, ph); macaron_step<1>(c, bar, ph); macaron_step<2>(c, bar, ph); macaron_step<3>(c, bar, ph);
    }
#ifdef PROBE_PHASE
    if (bx == 0 && tid == 0) { const unsigned d = MISC[17 + PROBE_PHASE] - MISC[16 + PROBE_PHASE]; const unsigned long long t0 = __builtin_amdgcn_s_memrealtime(); while (__builtin_amdgcn_s_memrealtime() - t0 < (unsigned long long)d * PROBE_AMP) __builtin_amdgcn_s_sleep(8); }
#endif
#undef IN
#undef SEAM
}

extern "C" void kernel_launch(void* const* d_in, const int* in_sizes, int n_in, void* d_out, int out_size, void* d_ws, size_t ws_size, hipStream_t stream) {
    static int grid = 0;
    if (grid == 0) {
        if (n_in != 14 || in_sizes[0] != ML * DM || out_size != ML * DM || ws_size < WS_END) { fprintf(stderr, "kernel_launch: shape/workspace mismatch (n_in %d, in0 %d, out %d, ws %zu, need %zu)\n", n_in, n_in > 0 ? in_sizes[0] : -1, out_size, ws_size, (size_t)WS_END); grid = -1; return; }
        int dev = 0, cus = 0, per_cu = 0;
        if (hipGetDevice(&dev) != hipSuccess || hipDeviceGetAttribute(&cus, hipDeviceAttributeMultiprocessorCount, dev) != hipSuccess) { grid = -1; return; }
        if (hipFuncSetAttribute((const void*)fwd, hipFuncAttributeMaxDynamicSharedMemorySize, LDS_BYTES) != hipSuccess) { fprintf(stderr, "kernel_launch: hipFuncSetAttribute failed\n"); grid = -1; return; }
        if (hipOccupancyMaxActiveBlocksPerMultiprocessor(&per_cu, (const void*)fwd, 512, LDS_BYTES) != hipSuccess || per_cu < 1) fprintf(stderr, "kernel_launch: occupancy query says %d\n", per_cu);
        (void)hipGetLastError();
        grid = cus;
    }
    if (grid < 0) return;
    (void)hipMemsetAsync((char*)d_ws + WS_CTL, 0, CTL_ZERO_BYTES, stream);
    Args a{};
    for (int i = 0; i < 14; ++i) a.in[i] = (const float*)d_in[i];
    a.out = (float*)d_out; a.ws = (unsigned char*)d_ws;
#if MK_ONE_LAUNCH
    a.ph_lo = 0; a.ph_hi = N_PHASES;
    hipLaunchKernelGGL(fwd, dim3(grid), dim3(512), LDS_BYTES, stream, a);
#else
    for (int p = 0; p < N_PHASES; ++p) { a.ph_lo = p; a.ph_hi = p + 1; hipLaunchKernelGGL(fwd, dim3(grid), dim3(512), LDS_BYTES, stream, a); }
#endif
    const hipError_t le = hipPeekAtLastError();
    if (le != hipSuccess) fprintf(stderr, "kernel_launch: launch failed: %s\n", hipGetErrorName(le));
}
```
